# Optimizing an MI355X kernel written in HIP

```python
import math
import jax, jax.numpy as jnp
from jax import lax
import numpy as np

D_MODEL = 2048
BATCH = 4
SEQ = 2048
DEPTH = 1
DEC_BATCH = 128
DEC_SEQ = 8
PAST_LEN = 16384
PAGE_SIZE = 128

RET_WIDTH = D_MODEL // 2
SGU_WIDTH = D_MODEL - RET_WIDTH
RET_HEADS = 8
RET_DK = RET_WIDTH // RET_HEADS
RET_DV = RET_WIDTH // RET_HEADS
SGU_GROUPS = 8
SGU_CH = SGU_WIDTH // SGU_GROUPS
CHUNK = 128
D_FF = 4 * D_MODEL
IN_WIDTH = 4 * RET_WIDTH + 2 * SGU_WIDTH
ROPE_THETA = 10000.0
EPS = 1e-6

kernel_name = "hybrid_retention_sgu_decoder_step"


def rmsnorm(x, g):
    xf = x.astype(jnp.float32)
    y = xf * lax.rsqrt(jnp.mean(xf * xf, axis=-1, keepdims=True) + EPS) * g.astype(jnp.float32)
    return y.astype(x.dtype)


def layernorm(x, g, b):
    xf = x.astype(jnp.float32)
    mu = jnp.mean(xf, axis=-1, keepdims=True)
    var = jnp.mean(jnp.square(xf - mu), axis=-1, keepdims=True)
    y = (xf - mu) * lax.rsqrt(var + EPS)
    if g is not None:
        y = y * g.astype(jnp.float32) + b.astype(jnp.float32)
    return y.astype(x.dtype)


def rotary(x, pos):
    d = x.shape[-1]
    inv = 1.0 / (ROPE_THETA ** (jnp.arange(0, d, 2, dtype=jnp.float32) / d))
    ang = pos.astype(jnp.float32)[:, None] * inv[None, :]
    cos = jnp.cos(ang)[None, :, None, :]
    sin = jnp.sin(ang)[None, :, None, :]
    xf = x.astype(jnp.float32)
    x1, x2 = xf[..., : d // 2], xf[..., d // 2:]
    return jnp.concatenate([x1 * cos - x2 * sin, x1 * sin + x2 * cos], axis=-1)


def retention(q, k, v, s0, clen):
    B, L, H, _ = q.shape
    n = L // clen

    def chunks(t):
        return t.astype(jnp.float32).reshape(B, n, clen, H, t.shape[-1]).transpose(1, 0, 3, 2, 4)

    qc, kc, vc = chunks(q), chunks(k), chunks(v)
    lg = jnp.log(1.0 - jnp.power(2.0, -5.0 - jnp.arange(H, dtype=jnp.float32)))
    idx = jnp.arange(clen, dtype=jnp.float32)
    diff = idx[:, None] - idx[None, :]
    dmask = jnp.where(diff[None] >= 0, jnp.exp(jnp.maximum(diff, 0.0)[None] * lg[:, None, None]), 0.0)
    cross = jnp.exp((idx + 1.0)[None, :] * lg[:, None])
    sdec = jnp.exp((clen - 1.0 - idx)[None, :] * lg[:, None])
    cdec = jnp.exp(clen * lg)

    def step(S, inp):
        qb, kb, vb = inp
        scores = jnp.einsum('bhnd,bhmd->bhnm', qb, kb) * dmask[None]
        o = jnp.einsum('bhnm,bhme->bhne', scores, vb) \
            + jnp.einsum('bhnd,bhde->bhne', qb, S) * cross[None, :, :, None]
        S_new = S * cdec[None, :, None, None] \
            + jnp.einsum('bhmd,bhme->bhde', kb * sdec[None, :, :, None], vb)
        return S_new, o

    S, o = lax.scan(step, s0.astype(jnp.float32), (qc, kc, vc))
    o = o.transpose(1, 0, 3, 2, 4).reshape(B, L, H, vc.shape[-1])
    return o, S


def spatial_gate(vn, w_s, b_s, clen):
    B, L, _ = vn.shape
    n = L // clen
    vr = vn.reshape(B, n, clen, SGU_GROUPS, SGU_CH)
    tri = jnp.tril(jnp.ones((clen, clen), dtype=w_s.dtype))
    w = w_s[:, :clen, :clen] * tri[None]
    s = jnp.einsum('gts,bnsgc->bntgc', w, vr) + b_s[:, :clen].T[None, None, :, :, None]
    return s.reshape(B, L, SGU_WIDTH)


def hybrid_layer(x, c, pos, s0, w_ada, b_ada, g_pre_mix, g_post_mix, g_pre_ffn, g_post_ffn,
                 w_in, w_s, b_s, ln_g, ln_b, w_o, w_ff1, w_ff2):
    B, L, _ = x.shape
    dt = x.dtype
    mod = (jax.nn.silu(c.astype(jnp.float32)) @ w_ada.astype(jnp.float32) + b_ada.astype(jnp.float32)).astype(dt)
    sh1, sc1, gt1, sh2, sc2, gt2 = jnp.split(mod[:, None, :], 6, axis=-1)

    h = rmsnorm(x, g_pre_mix) * (1 + sc1) + sh1
    z = h @ w_in
    q, k, v, g, u, vs = jnp.split(z, np.cumsum([RET_WIDTH] * 4 + [SGU_WIDTH])[:].tolist(), axis=-1)
    q = rotary(q.reshape(B, L, RET_HEADS, RET_DK), pos)
    k = rotary(k.reshape(B, L, RET_HEADS, RET_DK), pos) * (RET_DK ** -0.5)
    v = v.reshape(B, L, RET_HEADS, RET_DV)
    clen = min(CHUNK, L)
    o, S = retention(q, k, v, s0, clen)
    o = layernorm(o, None, None).astype(dt).reshape(B, L, RET_WIDTH)
    ret_out = jax.nn.silu(g) * o

    u = jax.nn.gelu(u)
    vn = layernorm(jax.nn.gelu(vs), ln_g, ln_b)
    sgu_out = u * spatial_gate(vn, w_s, b_s, clen)

    m = jnp.concatenate([ret_out, sgu_out], axis=-1) @ w_o
    x = x + gt1 * rmsnorm(m, g_post_mix)

    h2 = rmsnorm(x, g_pre_ffn) * (1 + sc2) + sh2
    f = jnp.square(jax.nn.relu(h2 @ w_ff1)) @ w_ff2
    x = x + gt2 * rmsnorm(f, g_post_ffn)
    return x, S, vn


def setup_inputs(seed: int = 0) -> dict:
    key = jax.random.key(seed)
    ks = jax.random.split(key, 24)
    f32 = jnp.float32
    nrm = lambda k, shape, s: jax.random.normal(k, shape, f32) * s
    return {
        "x_prompt": nrm(ks[0], (BATCH, SEQ, D_MODEL), 1.0),
        "x_sample": nrm(ks[1], (DEC_BATCH, DEC_SEQ, D_MODEL), 1.0),
        "state_ret": nrm(ks[2], (DEPTH, DEC_BATCH, RET_HEADS, RET_DK, RET_DV), 0.1),
        "c_prompt": nrm(ks[3], (BATCH, D_MODEL), 1.0),
        "c_sample": nrm(ks[4], (DEC_BATCH, D_MODEL), 1.0),
        "w_ada": nrm(ks[5], (DEPTH, D_MODEL, 6 * D_MODEL), D_MODEL ** -0.5),
        "b_ada": nrm(ks[6], (DEPTH, 6 * D_MODEL), 0.02),
        "g_pre_mix": 1.0 + nrm(ks[7], (DEPTH, D_MODEL), 0.02),
        "g_post_mix": 1.0 + nrm(ks[8], (DEPTH, D_MODEL), 0.02),
        "g_pre_ffn": 1.0 + nrm(ks[9], (DEPTH, D_MODEL), 0.02),
        "g_post_ffn": 1.0 + nrm(ks[10], (DEPTH, D_MODEL), 0.02),
        "w_in": nrm(ks[11], (DEPTH, D_MODEL, IN_WIDTH), D_MODEL ** -0.5),
        "w_s": nrm(ks[12], (DEPTH, SGU_GROUPS, CHUNK, CHUNK), 0.5 * CHUNK ** -0.5),
        "b_s": 1.0 + nrm(ks[13], (DEPTH, SGU_GROUPS, CHUNK), 0.02),
        "ln_g": 1.0 + nrm(ks[14], (DEPTH, SGU_WIDTH), 0.02),
        "ln_b": nrm(ks[15], (DEPTH, SGU_WIDTH), 0.02),
        "w_o": nrm(ks[16], (DEPTH, RET_WIDTH + SGU_WIDTH, D_MODEL), (RET_WIDTH + SGU_WIDTH) ** -0.5),
        "w_ff1": nrm(ks[17], (DEPTH, D_MODEL, D_FF), D_MODEL ** -0.5),
        "w_ff2": nrm(ks[18], (DEPTH, D_FF, D_MODEL), D_FF ** -0.5),
    }


def reference(x_prompt, x_sample, state_ret, c_prompt, c_sample, w_ada, b_ada, g_pre_mix,
              g_post_mix, g_pre_ffn, g_post_ffn, w_in, w_s, b_s, ln_g, ln_b, w_o, w_ff1, w_ff2):
    pos_prompt = jnp.arange(SEQ, dtype=jnp.int32)
    pos_sample = PAST_LEN + jnp.arange(DEC_SEQ, dtype=jnp.int32)
    yp, ys = x_prompt, x_sample
    sp_list, ss_list, vs_list = [], [], []
    for l in range(DEPTH):
        w = (w_ada[l], b_ada[l], g_pre_mix[l], g_post_mix[l], g_pre_ffn[l], g_post_ffn[l],
             w_in[l], w_s[l], b_s[l], ln_g[l], ln_b[l], w_o[l], w_ff1[l], w_ff2[l])
        s0_prompt = jnp.zeros((BATCH, RET_HEADS, RET_DK, RET_DV), jnp.float32)
        yp, sp, _ = hybrid_layer(yp, c_prompt, pos_prompt, s0_prompt, *w)
        ys, ss, vn_s = hybrid_layer(ys, c_sample, pos_sample, state_ret[l], *w)
        sp_list.append(sp)
        ss_list.append(ss)
        vs_list.append(vn_s)
    state_ret_prompt = jnp.stack(sp_list)
    state_ret_sample = jnp.stack(ss_list)
    sgu_v_sample = jnp.stack(vs_list)
    return (yp, ys, state_ret_prompt, state_ret_sample, sgu_v_sample)
```

```cpp
#include <hip/hip_runtime.h>
#include <hip/hip_cooperative_groups.h>
#include <cstdio>
#include <cstdint>
namespace cg = cooperative_groups;

#ifndef MK_MULTI
#define MK_MULTI 0
#endif

#define LAS __attribute__((address_space(3)))
typedef unsigned short bf16;
typedef unsigned v4u __attribute__((ext_vector_type(4)));
typedef unsigned v2u __attribute__((ext_vector_type(2)));
typedef float f32x4 __attribute__((ext_vector_type(4)));
typedef float f32x2 __attribute__((ext_vector_type(2)));
typedef short bf16x8 __attribute__((ext_vector_type(8)));
typedef short s16x4 __attribute__((ext_vector_type(4)));

namespace pg8 {
typedef unsigned short bf16_t;
typedef unsigned u32x4 __attribute__((ext_vector_type(4)));
constexpr int BM = 256, BK = 64, HALF = 128, HTB = HALF * BK * 2, STAGE_BYTES = 8 * HTB, NXCD = 8, WGM = 8;

__host__ __device__ __forceinline__ int lds_byte(int r, int c) { const int st = (r >> 4) * 2 + (c >> 5), rr = r & 15, cc = c & 31, ob = rr * 64 + cc * 2; return st * 1024 + (ob ^ (((ob >> 9) & 1) << 5)); }
__host__ __device__ __forceinline__ void stage_rc(int b, int& R, int& C) { const int st = b / 1024, sb = b % 1024, swz = sb ^ (((sb >> 9) & 1) << 5); R = (st >> 1) * 16 + swz / 64; C = (st & 1) * 32 + (swz % 64) / 2; }
__host__ __device__ __forceinline__ int perm32(int rho) { const int n = rho >> 4, i = rho & 15; return 8 * (i >> 2) + 4 * n + (i & 3); }

struct Unit { int pm, pn; };
struct Gemm { const bf16_t* A; const bf16_t* Bt; int M, N, K; };

struct StaticOrder {
    int nM, nN, nwg, G, c;
    __host__ __device__ void init(int M, int N, int G_, int c_) { nM = M / BM; nN = N / BM; nwg = nM * nN; G = G_; c = c_; }
    __host__ __device__ bool next(int i, Unit& u) const {
        const long L = (long)i * G + c; if (L >= nwg) return false;
        int wgid = (int)L; { const int q = nwg / NXCD, r = nwg % NXCD, xcd = wgid % NXCD, off = wgid / NXCD; wgid = (xcd < r ? xcd * (q + 1) : r * (q + 1) + (xcd - r) * q) + off; }
        const int nig = WGM * nN, gid = wgid / nig, fm = gid * WGM, gsz = (nM - fm) < WGM ? (nM - fm) : WGM;
        u.pm = fm + ((wgid % nig) % gsz); u.pn = (wgid % nig) / gsz; return true;
    }
    __device__ __forceinline__ void a_ready(const Unit&) const {}
    __device__ __forceinline__ void done(const Unit&) const {}
};

__device__ __forceinline__ unsigned cvt_pk_bf16(float lo, float hi) { unsigned r; asm volatile("v_cvt_pk_bf16_f32 %0, %1, %2" : "=v"(r) : "v"(lo), "v"(hi)); return r; }

__device__ __forceinline__ float sigmoidf_(float y) { return __builtin_amdgcn_rcpf(1.0f + __expf(-y)); }
__device__ __forceinline__ float silu_(float x) { return x * sigmoidf_(x); }
__device__ __forceinline__ float gelu_tanh_(float x) { return x * sigmoidf_(1.5957691216057308f * (x + 0.044715f * x * x * x)); }

template <int ACT> struct EpiBf16 {
    static constexpr bool PERM = true, AFTER_DRAIN = false;
    bf16_t* O; int ldc;
    __device__ __forceinline__ float act(float v, int sec) const {
        if (ACT == 1) { if (sec == 3) return silu_(v); if (sec >= 4) return gelu_tanh_(v); return v; }
        if (ACT == 2) { const float r = v > 0.f ? v : 0.f; return r * r; }
        return v;
    }
    __device__ __forceinline__ void operator()(const f32x4 (&acc)[2][2][4][2], const Unit& u, int wr, int wc, int fr, int fq) const {
        const int row0 = u.pm * BM + wr * 64 + fr; const int colt = u.pn * BM; const int sec = colt >> 10;
        const int col0 = colt + wc * 32 + 8 * fq;
#pragma unroll
        for (int ai = 0; ai < 2; ++ai)
#pragma unroll
            for (int m = 0; m < 4; ++m) { bf16_t* rowp = O + (size_t)(row0 + ai * HALF + m * 16) * ldc + col0;
#pragma unroll
                for (int bj = 0; bj < 2; ++bj) { f32x4 v0 = acc[ai][bj][m][0], v1 = acc[ai][bj][m][1];
                    if (ACT != 0) {
#pragma unroll
                        for (int e = 0; e < 4; ++e) { v0[e] = act(v0[e], sec); v1[e] = act(v1[e], sec); } }
                    u32x4 w; w.x = cvt_pk_bf16(v0[0], v0[1]); w.y = cvt_pk_bf16(v0[2], v0[3]); w.z = cvt_pk_bf16(v1[0], v1[1]); w.w = cvt_pk_bf16(v1[2], v1[3]);
                    *(u32x4*)(rowp + bj * HALF) = w; } }
    }
};

template <class Epi, class Sched, bool ALIGN_EPI = false, bool SP2 = false>
__device__ __forceinline__ void gemm_phase(LAS unsigned char* lds, const Gemm g, const Sched& S, const Epi& E) {
    const int tid = threadIdx.x, wid = __builtin_amdgcn_readfirstlane(tid >> 6), lane = tid & 63, wr = wid >> 2, wc = wid & 3, fr = lane & 15, fq = lane >> 4;
    const int K = g.K, nt = K / BK;
    unsigned voffA[2], voffB[2];
#pragma unroll
    for (int i = 0; i < 2; ++i) { int R, C; stage_rc(tid * 16 + i * 8192, R, C); const int Rb = Epi::PERM ? ((R & ~31) + perm32(R & 31)) : R;
        voffA[i] = (unsigned)(R * K + C) * 2u; voffB[i] = (unsigned)(Rb * K + C) * 2u; }
    const size_t kstep = (size_t)(BK * 2);
    const size_t hstep = (size_t)HALF * K * 2;
    const size_t tstep = 2 * hstep;
    const unsigned ldsw = (unsigned)wid * 1024u;
    const int aoff = lds_byte(wr * 64 + fr, fq * 8), boff = lds_byte(wc * 32 + fr, fq * 8);
#define PG8_SA(b, h) (((b) * 2 + (h)) * HTB)
#define PG8_SB(b, h) ((4 + (b) * 2 + (h)) * HTB)
#define PG8_STAGE(bufoff, gbase, voff) do { _Pragma("unroll") for (int _i = 0; _i < 2; ++_i) \
        __builtin_amdgcn_global_load_lds((const unsigned*)((const char*)(gbase) + (voff)[_i]), (LAS unsigned*)(lds + (bufoff) + ldsw + _i * 8192), 16, 0, 0); } while (0)
#define PG8_LDA(dst, b, h) do { _Pragma("unroll") for (int m = 0; m < 4; ++m) _Pragma("unroll") for (int k = 0; k < 2; ++k) dst[m][k] = *(const LAS bf16x8*)(lds + PG8_SA(b, h) + aoff + m * 2048 + k * 1024); } while (0)
#define PG8_LDB(dst, b, h) do { _Pragma("unroll") for (int n = 0; n < 2; ++n) _Pragma("unroll") for (int k = 0; k < 2; ++k) dst[n][k] = *(const LAS bf16x8*)(lds + PG8_SB(b, h) + boff + n * 2048 + k * 1024); } while (0)
#define PG8_MMA(ai, bj, At, Bt) do { __builtin_amdgcn_s_setprio(1); _Pragma("unroll") for (int m = 0; m < 4; ++m) _Pragma("unroll") for (int n = 0; n < 2; ++n) _Pragma("unroll") for (int k = 0; k < 2; ++k) \
        acc[ai][bj][m][n] = __builtin_amdgcn_mfma_f32_16x16x32_bf16(Bt[n][k], At[m][k], acc[ai][bj][m][n], 0, 0, 0); __builtin_amdgcn_s_setprio(0); } while (0)
#define PG8_WAIT_V(n) asm volatile("s_waitcnt vmcnt(" #n ")" ::: "memory")
#define PG8_WAIT_L(n) asm volatile("s_waitcnt lgkmcnt(" #n ")" ::: "memory")
#define PG8_BAR __builtin_amdgcn_s_barrier()
#define PG8_SCHED __builtin_amdgcn_sched_barrier(0)
    Unit cur, nxt; int ui = 0;
    if (!S.next(0, cur)) return;
    f32x4 acc[2][2][4][2];
#pragma unroll
    for (int a = 0; a < 2; ++a)
#pragma unroll
        for (int b = 0; b < 2; ++b)
#pragma unroll
            for (int m = 0; m < 4; ++m)
#pragma unroll
                for (int n = 0; n < 2; ++n) acc[a][b][m][n] = (f32x4){0.f, 0.f, 0.f, 0.f};
    bf16x8 At[4][2], B0[2][2], B1[2][2];
    const char* cA = (const char*)g.A + (size_t)cur.pm * tstep; const char* cB = (const char*)g.Bt + (size_t)cur.pn * tstep;
    S.a_ready(cur);
    if constexpr (SP2) {
        PG8_STAGE(PG8_SB(0, 0), cB, voffB); PG8_STAGE(PG8_SB(0, 1), cB + hstep, voffB); PG8_STAGE(PG8_SA(0, 0), cA, voffA); PG8_STAGE(PG8_SA(0, 1), cA + hstep, voffA);
        if (wr == 1) PG8_BAR;
        PG8_WAIT_V(2); PG8_BAR;
        PG8_STAGE(PG8_SB(1, 0), cB + kstep, voffB); PG8_STAGE(PG8_SA(1, 0), cA + kstep, voffA); PG8_STAGE(PG8_SB(1, 1), cB + hstep + kstep, voffB);
        PG8_WAIT_V(6); PG8_BAR;
    } else {
        PG8_STAGE(PG8_SB(0, 0), cB, voffB); PG8_STAGE(PG8_SA(0, 0), cA, voffA); PG8_STAGE(PG8_SB(0, 1), cB + hstep, voffB); PG8_STAGE(PG8_SA(0, 1), cA + hstep, voffA);
        if (wr == 1) PG8_BAR;
        PG8_WAIT_V(4); PG8_BAR;
        PG8_STAGE(PG8_SB(1, 0), cB + kstep, voffB); PG8_STAGE(PG8_SA(1, 0), cA + kstep, voffA); PG8_STAGE(PG8_SB(1, 1), cB + hstep + kstep, voffB);
        PG8_WAIT_V(6); PG8_BAR;
    }
    for (;;) {
        const bool has_next = S.next(ui + 1, nxt);
        const char* nA = has_next ? (const char*)g.A + (size_t)nxt.pm * tstep : cA; const char* nB = has_next ? (const char*)g.Bt + (size_t)nxt.pn * tstep : cB;
        for (int t = 0; t < nt; t += 2) {
            const bool last = (t == nt - 2);
            const char* a1 = cA + (size_t)(t + 1) * kstep;
            const char* a2 = last ? nA : cA + (size_t)(t + 2) * kstep; const char* b2 = last ? nB : cB + (size_t)(t + 2) * kstep;
            const char* a3 = a2 + kstep; const char* b3 = b2 + kstep;
            if (last && has_next) S.a_ready(nxt);
            if constexpr (SP2) {
            PG8_LDB(B0, 0, 0); PG8_LDB(B1, 0, 1); PG8_SCHED; PG8_LDA(At, 0, 0); PG8_STAGE(PG8_SA(1, 1), a1 + hstep, voffA);
            PG8_WAIT_V(8); PG8_WAIT_L(0); PG8_BAR; PG8_MMA(0, 0, At, B0); PG8_MMA(0, 1, At, B1); PG8_BAR; PG8_SCHED;
            PG8_LDA(At, 0, 1); PG8_STAGE(PG8_SB(0, 0), b2, voffB); PG8_STAGE(PG8_SB(0, 1), b2 + hstep, voffB); PG8_STAGE(PG8_SA(0, 0), a2, voffA);
            PG8_WAIT_V(8); PG8_WAIT_L(0); PG8_BAR; PG8_MMA(1, 0, At, B0); PG8_MMA(1, 1, At, B1); PG8_BAR; PG8_SCHED;
            PG8_LDB(B0, 1, 0); PG8_LDB(B1, 1, 1); PG8_SCHED; PG8_LDA(At, 1, 0); PG8_STAGE(PG8_SA(0, 1), a2 + hstep, voffA);
            PG8_WAIT_V(8); PG8_WAIT_L(0); PG8_BAR; PG8_MMA(0, 0, At, B0); PG8_MMA(0, 1, At, B1); PG8_BAR; PG8_SCHED;
            PG8_LDA(At, 1, 1); PG8_STAGE(PG8_SB(1, 0), b3, voffB); PG8_STAGE(PG8_SB(1, 1), b3 + hstep, voffB); PG8_STAGE(PG8_SA(1, 0), a3, voffA);
            PG8_WAIT_V(8); PG8_WAIT_L(0); PG8_BAR; PG8_MMA(1, 0, At, B0); PG8_MMA(1, 1, At, B1); PG8_BAR; PG8_SCHED;
            } else {
            PG8_LDB(B0, 0, 0); PG8_SCHED; PG8_LDA(At, 0, 0); PG8_STAGE(PG8_SA(1, 1), a1 + hstep, voffA);
            PG8_WAIT_L(8); PG8_BAR; PG8_WAIT_L(0); PG8_MMA(0, 0, At, B0); PG8_BAR; PG8_SCHED;
            PG8_LDB(B1, 0, 1); PG8_STAGE(PG8_SB(0, 0), b2, voffB);
            PG8_BAR; PG8_WAIT_L(0); PG8_MMA(0, 1, At, B1); PG8_BAR;
            PG8_LDA(At, 0, 1); PG8_STAGE(PG8_SA(0, 0), a2, voffA);
            PG8_BAR; PG8_WAIT_L(0); PG8_MMA(1, 0, At, B0); PG8_BAR; PG8_SCHED;
            PG8_STAGE(PG8_SB(0, 1), b2 + hstep, voffB);
            PG8_WAIT_V(6); PG8_BAR; PG8_MMA(1, 1, At, B1); PG8_BAR;
            PG8_LDB(B0, 1, 0); PG8_SCHED; PG8_LDA(At, 1, 0); PG8_STAGE(PG8_SA(0, 1), a2 + hstep, voffA);
            PG8_WAIT_L(8); PG8_BAR; PG8_WAIT_L(0); PG8_MMA(0, 0, At, B0); PG8_BAR; PG8_SCHED;
            PG8_LDB(B1, 1, 1); PG8_STAGE(PG8_SB(1, 0), b3, voffB);
            PG8_BAR; PG8_WAIT_L(0); PG8_MMA(0, 1, At, B1); PG8_BAR;
            PG8_LDA(At, 1, 1); PG8_STAGE(PG8_SA(1, 0), a3, voffA);
            PG8_BAR; PG8_WAIT_L(0); PG8_MMA(1, 0, At, B0); PG8_BAR; PG8_SCHED;
            PG8_STAGE(PG8_SB(1, 1), b3 + hstep, voffB);
            PG8_WAIT_V(6); PG8_BAR; PG8_MMA(1, 1, At, B1); PG8_BAR;
            }
        }
        if constexpr (ALIGN_EPI) { if (wr == 0) PG8_BAR; }
        if constexpr (!Epi::AFTER_DRAIN) { E(acc, cur, wr, wc, fr, fq); S.done(cur); }
        if (!has_next) break;
#pragma unroll
        for (int a = 0; a < 2; ++a)
#pragma unroll
            for (int b = 0; b < 2; ++b)
#pragma unroll
                for (int m = 0; m < 4; ++m)
#pragma unroll
                    for (int n = 0; n < 2; ++n) acc[a][b][m][n] = (f32x4){0.f, 0.f, 0.f, 0.f};
        cur = nxt; cA = nA; cB = nB; ++ui;
        if constexpr (ALIGN_EPI) { if (wr == 1) PG8_BAR; }
    }
    PG8_WAIT_V(0);
    if constexpr (!ALIGN_EPI) { if (wr == 0) PG8_BAR; }
    PG8_BAR;
#undef PG8_SA
#undef PG8_SB
#undef PG8_STAGE
#undef PG8_LDA
#undef PG8_LDB
#undef PG8_MMA
#undef PG8_WAIT_V
#undef PG8_WAIT_L
#undef PG8_BAR
#undef PG8_SCHED
}
}

constexpr int NWAVES = 8, NTHREADS = 512;
constexpr int D = 2048, MP = 8192, MS = 1024, M = MP + MS, LP = 2048, LS = 8, BP = 4, BS = 128;
constexpr int INW = 6144, DFF = 8192, NH = 8, DK = 128, SGW = 1024, NMOD = 6 * D, NMODROWS = BP + BS;
constexpr int NCH = LP / 128;
constexpr int PAST = 16384;
constexpr float EPS = 1e-6f;
constexpr int ZQ = 0, ZK = 1024, ZV = 2048, ZG = 3072, ZU = 4096, ZVS = 5120;
constexpr size_t OUT_Y = 0, OUT_SP = (size_t)M * D, OUT_SS = OUT_SP + (size_t)BP * NH * DK * DK, OUT_VN = OUT_SS + (size_t)BS * NH * DK * DK;
constexpr size_t MiB = 1u << 20;
constexpr size_t WS_WIN = 1 * MiB, WS_WO = 25 * MiB, WS_W1 = 33 * MiB, WS_W2 = 65 * MiB, WS_MOD = 97 * MiB, WS_ROPE = 104 * MiB;
constexpr size_t WS_H = 106 * MiB, WS_CAT = 142 * MiB, WS_MB = 178 * MiB, WS_VN = 214 * MiB, WS_Z = 230 * MiB, WS_KV = 338 * MiB, WS_SPV = 370 * MiB;
constexpr size_t WS_F1 = 230 * MiB, WS_END = 386 * MiB;
static_assert(WS_F1 + (size_t)M * DFF * 2 <= WS_END, "f1 overlay");
static_assert(WS_Z + (size_t)M * INW * 2 <= WS_KV, "z");
constexpr int LDS_BYTES = 147456;
constexpr int RS = 272, TILE_B = 128 * RS;
static_assert(4 * TILE_B <= LDS_BYTES, "tiles");

struct Args { const float* in[19]; float* out; unsigned char* ws; int ph_lo, ph_hi; };

__device__ __forceinline__ unsigned pk2(float lo, float hi) { return pg8::cvt_pk_bf16(lo, hi); }
__device__ __forceinline__ float bf_lo(unsigned u) { return __uint_as_float(u << 16); }
__device__ __forceinline__ float bf_hi(unsigned u) { return __uint_as_float(u & 0xffff0000u); }
__device__ __forceinline__ float bf1(bf16 b) { return __uint_as_float(((unsigned)b) << 16); }
__device__ __forceinline__ bf16 f2bf(float f) { return (bf16)(pk2(f, 0.f) & 0xffffu); }
__device__ __forceinline__ float wave_sum(float v) {
#pragma unroll
    for (int o = 1; o < 64; o <<= 1) v += __shfl_xor(v, o);
    return v;
}
__device__ __forceinline__ float sum16(float v) { v += __shfl_xor(v, 1); v += __shfl_xor(v, 2); v += __shfl_xor(v, 4); v += __shfl_xor(v, 8); return v; }
__device__ __forceinline__ float log2gamma(int h) { return log2f(1.0f - exp2f(-5.0f - (float)h)); }
__device__ __forceinline__ int modrow(int m) { return m < MP ? (m >> 11) : BP + ((m - MP) >> 3); }

__device__ __forceinline__ bf16x8 ld_row(LAS unsigned char* tile, int r0, int k0, int lane) {
    return *(const LAS bf16x8*)(tile + (r0 + (lane & 15)) * RS + (k0 + 8 * (lane >> 4)) * 2);
}
__device__ __forceinline__ unsigned tr_base(LAS unsigned char* tile, int c0, int lane) {
    const int g = lane >> 4, i = lane & 15, q = i >> 2, p = i & 3;
    return (unsigned)(uintptr_t)(tile + (8 * g + q) * RS + (c0 + 4 * p) * 2);
}
__device__ __forceinline__ bf16x8 ld_tr(unsigned base, const int OFF) {
    s16x4 lo, hi;
    asm volatile("ds_read_b64_tr_b16 %0, %2 offset:%3\n\tds_read_b64_tr_b16 %1, %2 offset:%4\n\ts_waitcnt lgkmcnt(0)" : "=&v"(lo), "=&v"(hi) : "v"(base), "n"(OFF), "n"(OFF + 4 * RS) : "memory");
    return __builtin_shufflevector(lo, hi, 0, 1, 2, 3, 4, 5, 6, 7);
}
static_assert(4 * RS == 1088, "tr offset");
#define MFMA16(a, b, c) __builtin_amdgcn_mfma_f32_16x16x32_bf16((a), (b), (c), 0, 0, 0)

__device__ __forceinline__ void stage_copy(LAS unsigned char* tile, const bf16* src, size_t stride, int tid) {
#pragma unroll
    for (int it = 0; it < 4; ++it) { const int idx = tid + NTHREADS * it, r = idx >> 4, ch = idx & 15;
        *(LAS v4u*)(tile + r * RS + 16 * ch) = *(const v4u*)(src + (size_t)r * stride + 8 * ch); }
}
template <bool SDEC>
__device__ __forceinline__ void stage_rot(LAS unsigned char* tile, const bf16* src  , const float* rope  , float scale, float l2g, int tid) {
#pragma unroll
    for (int it = 0; it < 2; ++it) {
        const int idx = tid + NTHREADS * it, r = idx >> 3, ch = idx & 7;
        const bf16* s = src + (size_t)r * INW + 8 * ch;
        const v4u x1 = *(const v4u*)s, x2 = *(const v4u*)(s + 64);
        const f32x4* cs = (const f32x4*)(rope + ((size_t)r * 64 + 8 * ch) * 2);
        const float rs = SDEC ? scale * exp2f((float)(127 - r) * l2g) : scale;
        v4u o1, o2;
#pragma unroll
        for (int e = 0; e < 4; ++e) {
            const f32x4 c = cs[e];
            const float a0 = bf_lo(x1[e]), a1 = bf_hi(x1[e]), b0 = bf_lo(x2[e]), b1 = bf_hi(x2[e]);
            o1[e] = pk2((a0 * c[0] - b0 * c[1]) * rs, (a1 * c[2] - b1 * c[3]) * rs);
            o2[e] = pk2((a0 * c[1] + b0 * c[0]) * rs, (a1 * c[3] + b1 * c[2]) * rs);
        }
        *(LAS v4u*)(tile + r * RS + 16 * ch) = o1;
        *(LAS v4u*)(tile + r * RS + 128 + 16 * ch) = o2;
    }
}

__device__ __forceinline__ void p0_transpose_item(const float* W, int K, int N, bf16* WT, LAS float* scr, int item, int lane) {
    const int nblk = N / 32, kb = item / nblk, nb = item % nblk, k0 = 64 * kb, n0 = 32 * nb;
#pragma unroll 8
    for (int i = 0; i < 32; ++i) { const int kk = 2 * i + (lane >> 5); scr[kk * 33 + (lane & 31)] = W[(size_t)(k0 + kk) * N + n0 + (lane & 31)]; }
    asm volatile("s_waitcnt lgkmcnt(0)" ::: "memory");
    const int c = lane & 7;
#pragma unroll
    for (int j = 0; j < 4; ++j) { const int n = (lane >> 3) + 8 * j; const LAS float* s = scr + (8 * c) * 33 + n;
        v4u o; o.x = pk2(s[0 * 33], s[1 * 33]); o.y = pk2(s[2 * 33], s[3 * 33]); o.z = pk2(s[4 * 33], s[5 * 33]); o.w = pk2(s[6 * 33], s[7 * 33]);
        *(v4u*)(WT + (size_t)(n0 + n) * K + k0 + 8 * c) = o; }
    asm volatile("s_waitcnt lgkmcnt(0)" ::: "memory");
}

__device__ __forceinline__ void p0_mod_slab(const Args& a, LAS unsigned char* lds, int slab, int tid, int wave, int lane) {
    const float* cp = a.in[3]; const float* cs = a.in[4]; const float* wada = a.in[5]; const float* bada = a.in[6];
    float* mod = (float*)(a.ws + WS_MOD);
    LAS float* red = (LAS float*)(lds + 67584);
    const int n0 = slab * 64, j = lane & 15, kq = lane >> 4;
    f32x4 acc[9][4];
#pragma unroll
    for (int mt = 0; mt < 9; ++mt)
#pragma unroll
        for (int jj = 0; jj < 4; ++jj) acc[mt][jj] = (f32x4){0.f, 0.f, 0.f, 0.f};
    for (int ks = 0; ks < 8; ++ks) {
        const int k0 = 256 * wave + 32 * ks + 8 * kq;
        f32x4 wv[8];
#pragma unroll
        for (int i = 0; i < 8; ++i) wv[i] = *(const f32x4*)(wada + (size_t)(k0 + i) * NMOD + n0 + 4 * j);
        bf16x8 bop[4];
#pragma unroll
        for (int jj = 0; jj < 4; ++jj) { v4u w; w.x = pk2(wv[0][jj], wv[1][jj]); w.y = pk2(wv[2][jj], wv[3][jj]); w.z = pk2(wv[4][jj], wv[5][jj]); w.w = pk2(wv[6][jj], wv[7][jj]); bop[jj] = __builtin_bit_cast(bf16x8, w); }
#pragma unroll
        for (int mt = 0; mt < 9; ++mt) {
            int r = 16 * mt + j; r = r < NMODROWS ? r : NMODROWS - 1;
            const float* crow = r < BP ? cp + (size_t)r * D : cs + (size_t)(r - BP) * D;
            const f32x4 c0 = *(const f32x4*)(crow + k0), c1 = *(const f32x4*)(crow + k0 + 4);
            v4u w; w.x = pk2(pg8::silu_(c0[0]), pg8::silu_(c0[1])); w.y = pk2(pg8::silu_(c0[2]), pg8::silu_(c0[3]));
            w.z = pk2(pg8::silu_(c1[0]), pg8::silu_(c1[1])); w.w = pk2(pg8::silu_(c1[2]), pg8::silu_(c1[3]));
            const bf16x8 aop = __builtin_bit_cast(bf16x8, w);
#pragma unroll
            for (int jj = 0; jj < 4; ++jj) acc[mt][jj] = MFMA16(aop, bop[jj], acc[mt][jj]);
        }
    }
    for (int w = 0; w < 8; ++w) {
        if (wave == w) {
#pragma unroll
            for (int mt = 0; mt < 9; ++mt)
#pragma unroll
                for (int r = 0; r < 4; ++r) {
                    LAS f32x4* p = (LAS f32x4*)(red + (16 * mt + 4 * kq + r) * 64 + 4 * j);
                    f32x4 v = (f32x4){acc[mt][0][r], acc[mt][1][r], acc[mt][2][r], acc[mt][3][r]};
                    if (w) v += *p;
                    *p = v;
                }
        }
        __syncthreads();
    }
    for (int idx = tid; idx < NMODROWS * 64; idx += NTHREADS) { const int row = idx >> 6, col = idx & 63; mod[(size_t)row * NMOD + n0 + col] = red[idx] + bada[n0 + col]; }
    __syncthreads();
}

__device__ __forceinline__ void p0_prologue(const Args& a, LAS unsigned char* lds, int G, int bid, int tid, int wave, int lane) {
    for (int slab = bid; slab < NMOD / 64; slab += G) p0_mod_slab(a, lds, slab, tid, wave, lane);
    {
        float* rope = (float*)(a.ws + WS_ROPE);
        for (int idx = bid * NTHREADS + tid; idx < (LP + LS) * 64; idx += G * NTHREADS) {
            const int p = idx >> 6, jf = idx & 63; const int pos = p < LP ? p : PAST + (p - LP);
            const double inv = exp2(-(double)jf * (13.287712379549449 / 64.0));
            const double ang = (double)pos * inv;
            const double n = rint(ang * 0.15915494309189535);
            double r = fma(-n, 6.283185307179586, ang); r = fma(-n, 2.4492935982947064e-16, r);
            rope[2 * idx] = (float)cos(r); rope[2 * idx + 1] = (float)sin(r);
        }
    }
    LAS float* scr = (LAS float*)(lds + wave * 8448);
    const int gw = bid * NWAVES + wave, NGW = G * NWAVES;
    constexpr int I_IN = (D / 64) * (INW / 32), I_O = (D / 64) * (D / 32), I_1 = (D / 64) * (DFF / 32), I_2 = (DFF / 64) * (D / 32);
    for (int it = gw; it < I_IN + I_O + I_1 + I_2; it += NGW) {
        int r = it;
        if (r < I_IN) { p0_transpose_item(a.in[11], D, INW, (bf16*)(a.ws + WS_WIN), scr, r, lane); continue; } r -= I_IN;
        if (r < I_O) { p0_transpose_item(a.in[16], D, D, (bf16*)(a.ws + WS_WO), scr, r, lane); continue; } r -= I_O;
        if (r < I_1) { p0_transpose_item(a.in[17], D, DFF, (bf16*)(a.ws + WS_W1), scr, r, lane); continue; } r -= I_1;
        p0_transpose_item(a.in[18], DFF, D, (bf16*)(a.ws + WS_W2), scr, r, lane);
    }
}

__device__ __forceinline__ const float* xrow(const Args& a, int m) { return m < MP ? a.in[0] + (size_t)m * D : a.in[1] + (size_t)(m - MP) * D; }

__device__ __forceinline__ void p1_rows(const Args& a, int G, int bid, int wave, int lane) {
    const float* mod = (const float*)(a.ws + WS_MOD); const float* g = a.in[7]; bf16* H = (bf16*)(a.ws + WS_H);
    for (int m = bid * NWAVES + wave; m < M; m += G * NWAVES) {
        const f32x4* xr = (const f32x4*)xrow(a, m) + lane; const float* md = mod + (size_t)modrow(m) * NMOD;
        f32x4 v[8]; float ss = 0.f;
#pragma unroll
        for (int j = 0; j < 8; ++j) { v[j] = xr[64 * j]; ss += (v[j][0] * v[j][0] + v[j][1] * v[j][1]) + (v[j][2] * v[j][2] + v[j][3] * v[j][3]); }
        const float rstd = 1.0f / sqrtf(wave_sum(ss) * (1.0f / D) + EPS);
#pragma unroll
        for (int j = 0; j < 8; ++j) { const int col = 4 * (lane + 64 * j);
            const f32x4 gg = *(const f32x4*)(g + col), sh = *(const f32x4*)(md + col), sc = *(const f32x4*)(md + D + col);
            const f32x4 o = v[j] * rstd * gg * (sc + 1.0f) + sh;
            v2u w; w.x = pk2(o[0], o[1]); w.y = pk2(o[2], o[3]); *(v2u*)(H + (size_t)m * D + col) = w; }
    }
}
__device__ __forceinline__ void p7_rows(const Args& a, int G, int bid, int wave, int lane) {
    const float* mod = (const float*)(a.ws + WS_MOD); const float* gpost = a.in[8]; const float* gpre = a.in[9];
    bf16* H = (bf16*)(a.ws + WS_H); const bf16* MB = (const bf16*)(a.ws + WS_MB);
    for (int m = bid * NWAVES + wave; m < M; m += G * NWAVES) {
        const f32x4* xr = (const f32x4*)xrow(a, m) + lane; const float* md = mod + (size_t)modrow(m) * NMOD;
        const v2u* mr = (const v2u*)(MB + (size_t)m * D) + lane;
        f32x4 v[8]; float ss = 0.f;
#pragma unroll
        for (int j = 0; j < 8; ++j) { const v2u w = mr[64 * j]; v[j] = (f32x4){bf_lo(w.x), bf_hi(w.x), bf_lo(w.y), bf_hi(w.y)}; ss += (v[j][0] * v[j][0] + v[j][1] * v[j][1]) + (v[j][2] * v[j][2] + v[j][3] * v[j][3]); }
        const float rstd = 1.0f / sqrtf(wave_sum(ss) * (1.0f / D) + EPS);
        float s2 = 0.f;
#pragma unroll
        for (int j = 0; j < 8; ++j) { const int col = 4 * (lane + 64 * j);
            const f32x4 gg = *(const f32x4*)(gpost + col), gt = *(const f32x4*)(md + 2 * D + col);
            const f32x4 x1 = xr[64 * j] + gt * (v[j] * rstd * gg);
            v[j] = x1; s2 += (x1[0] * x1[0] + x1[1] * x1[1]) + (x1[2] * x1[2] + x1[3] * x1[3]);
            *(f32x4*)(a.out + OUT_Y + (size_t)m * D + col) = x1; }
        const float rstd2 = 1.0f / sqrtf(wave_sum(s2) * (1.0f / D) + EPS);
#pragma unroll
        for (int j = 0; j < 8; ++j) { const int col = 4 * (lane + 64 * j);
            const f32x4 gg = *(const f32x4*)(gpre + col), sh = *(const f32x4*)(md + 3 * D + col), sc = *(const f32x4*)(md + 4 * D + col);
            const f32x4 o = v[j] * rstd2 * gg * (sc + 1.0f) + sh;
            v2u w; w.x = pk2(o[0], o[1]); w.y = pk2(o[2], o[3]); *(v2u*)(H + (size_t)m * D + col) = w; }
    }
}
__device__ __forceinline__ void p10_rows(const Args& a, int G, int bid, int wave, int lane) {
    const float* mod = (const float*)(a.ws + WS_MOD); const float* gpost = a.in[10]; const bf16* MB = (const bf16*)(a.ws + WS_MB);
    for (int m = bid * NWAVES + wave; m < M; m += G * NWAVES) {
        f32x4* yr = (f32x4*)(a.out + OUT_Y + (size_t)m * D) + lane; const float* md = mod + (size_t)modrow(m) * NMOD;
        const v2u* mr = (const v2u*)(MB + (size_t)m * D) + lane;
        f32x4 v[8]; float ss = 0.f;
#pragma unroll
        for (int j = 0; j < 8; ++j) { const v2u w = mr[64 * j]; v[j] = (f32x4){bf_lo(w.x), bf_hi(w.x), bf_lo(w.y), bf_hi(w.y)}; ss += (v[j][0] * v[j][0] + v[j][1] * v[j][1]) + (v[j][2] * v[j][2] + v[j][3] * v[j][3]); }
        const float rstd = 1.0f / sqrtf(wave_sum(ss) * (1.0f / D) + EPS);
#pragma unroll
        for (int j = 0; j < 8; ++j) { const int col = 4 * (lane + 64 * j);
            const f32x4 gg = *(const f32x4*)(gpost + col), gt = *(const f32x4*)(md + 5 * D + col);
            yr[64 * j] = yr[64 * j] + gt * (v[j] * rstd * gg); }
    }
}

__device__ __forceinline__ void vn_row(const bf16* zrow, const float* lng, const float* lnb, int lane, float (&o)[2][8]) {
    float s = 0.f;
#pragma unroll
    for (int jj = 0; jj < 2; ++jj) { const v4u w = *(const v4u*)(zrow + ZVS + 8 * (lane + 64 * jj));
#pragma unroll
        for (int e = 0; e < 4; ++e) { o[jj][2 * e] = bf_lo(w[e]); o[jj][2 * e + 1] = bf_hi(w[e]); s += o[jj][2 * e] + o[jj][2 * e + 1]; } }
    const float mean = wave_sum(s) * (1.0f / SGW); float q = 0.f;
#pragma unroll
    for (int jj = 0; jj < 2; ++jj)
#pragma unroll
        for (int e = 0; e < 8; ++e) { o[jj][e] -= mean; q += o[jj][e] * o[jj][e]; }
    const float rstd = 1.0f / sqrtf(wave_sum(q) * (1.0f / SGW) + EPS);
#pragma unroll
    for (int jj = 0; jj < 2; ++jj) { const int col = 8 * (lane + 64 * jj);
#pragma unroll
        for (int e = 0; e < 8; ++e) o[jj][e] = o[jj][e] * rstd * lng[col + e] + lnb[col + e]; }
}

__device__ __forceinline__ void p3_phase(const Args& a, LAS unsigned char* lds, int G, int bid, int tid, int wave, int lane) {
    const bf16* Z = (const bf16*)(a.ws + WS_Z); const float* rope = (const float*)(a.ws + WS_ROPE);
    float* KV = (float*)(a.ws + WS_KV); bf16* CAT = (bf16*)(a.ws + WS_CAT); bf16* VN = (bf16*)(a.ws + WS_VN);
    const float* lng = a.in[14]; const float* lnb = a.in[15];
    const int j = lane & 15, rq = lane >> 4;
    LAS unsigned char* t0 = lds; LAS unsigned char* t1 = lds + TILE_B;
    constexpr int NT_KV = BP * NH * NCH, NT_SB = BS, NT_SR = BS * NH / 4;
    for (int T = bid; T < NT_KV + NT_SB + NT_SR; T += G) {
        if (T < NT_KV) {
            const int c = T % NCH, h = (T / NCH) % NH, b = T / (NCH * NH);
            const size_t row0 = (size_t)b * LP + c * 128; const float l2g = log2gamma(h);
            stage_rot<true>(t0, Z + row0 * INW + ZK + h * DK, rope + (size_t)(c * 128) * 128, 0.08838834764831845f, l2g, tid);
            stage_copy(t1, Z + row0 * INW + ZV + h * DK, INW, tid);
            __syncthreads();
            f32x4 acc[8];
            const unsigned trA = tr_base(t0, 16 * wave, lane), trB_t1 = tr_base(t1, 0, lane);
#pragma unroll
            for (int nt = 0; nt < 8; ++nt) acc[nt] = (f32x4){0.f, 0.f, 0.f, 0.f};
#pragma unroll
            for (int ks = 0; ks < 4; ++ks) { const bf16x8 aop = ld_tr(trA, ks * (32 * RS));
#pragma unroll
                for (int nt = 0; nt < 8; ++nt) { const bf16x8 bop = ld_tr(trB_t1, ks * (32 * RS) + nt * 32); acc[nt] = MFMA16(aop, bop, acc[nt]); } }
            float* kv = KV + (size_t)T * (DK * DK);
#pragma unroll
            for (int nt = 0; nt < 8; ++nt)
#pragma unroll
                for (int r = 0; r < 4; ++r) kv[(16 * wave + 4 * rq + r) * DK + 16 * nt + j] = acc[nt][r];
            __syncthreads();
        } else if (T < NT_KV + NT_SB) {
            const int b = T - NT_KV; const int row = MP + b * LS + wave; const bf16* zrow = Z + (size_t)row * INW;
            LAS float* vl = (LAS float*)lds;
            float o[2][8]; vn_row(zrow, lng, lnb, lane, o);
#pragma unroll
            for (int jj = 0; jj < 2; ++jj) { const int col = 8 * (lane + 64 * jj);
                float* dst = a.out + OUT_VN + (size_t)(b * LS + wave) * SGW + col;
                *(f32x4*)dst = (f32x4){o[jj][0], o[jj][1], o[jj][2], o[jj][3]}; *(f32x4*)(dst + 4) = (f32x4){o[jj][4], o[jj][5], o[jj][6], o[jj][7]};
                *(LAS f32x4*)(vl + wave * SGW + col) = (f32x4){o[jj][0], o[jj][1], o[jj][2], o[jj][3]}; *(LAS f32x4*)(vl + wave * SGW + col + 4) = (f32x4){o[jj][4], o[jj][5], o[jj][6], o[jj][7]}; }
            __syncthreads();
            const float* ws_ = a.in[12]; const float* bs_ = a.in[13];
#pragma unroll
            for (int jj = 0; jj < 2; ++jj) { const int col = 8 * (lane + 64 * jj), g = col >> 7;
                float s[8]; const float bias = bs_[g * 128 + wave];
#pragma unroll
                for (int e = 0; e < 8; ++e) s[e] = bias;
                for (int sp = 0; sp <= wave; ++sp) { const float w = ws_[(size_t)g * 16384 + wave * 128 + sp];
                    const f32x4 v0 = *(const LAS f32x4*)(vl + sp * SGW + col), v1 = *(const LAS f32x4*)(vl + sp * SGW + col + 4);
                    s[0] += w * v0[0]; s[1] += w * v0[1]; s[2] += w * v0[2]; s[3] += w * v0[3]; s[4] += w * v1[0]; s[5] += w * v1[1]; s[6] += w * v1[2]; s[7] += w * v1[3]; }
                const v4u u = *(const v4u*)(zrow + ZU + col); v4u w;
#pragma unroll
                for (int e = 0; e < 4; ++e) w[e] = pk2(s[2 * e] * bf_lo(u[e]), s[2 * e + 1] * bf_hi(u[e]));
                *(v4u*)(CAT + (size_t)row * D + SGW + col) = w; }
            __syncthreads();
        } else {
            const int t4 = T - NT_KV - NT_SB; const int pr = wave >> 1, eh = wave & 1; const int bh = 4 * t4 + pr, b = bh >> 3, h = bh & 7;
            const int e = 64 * eh + lane; const size_t row0 = (size_t)MP + (size_t)b * LS; const float l2g = log2gamma(h);
            LAS float* qT = (LAS float*)(lds + pr * 8192);
            LAS float* kT = (LAS float*)(lds + pr * 8192 + 4096);
            LAS float* scl = (LAS float*)(lds + 32768 + wave * 256);
            LAS float* part = (LAS float*)(lds + 36864);
            {
                const int colb = (eh ? ZK : ZQ) + h * DK; const float sc = eh ? 0.08838834764831845f : 1.0f; LAS float* dst = eh ? kT : qT;
#pragma unroll
                for (int n = 0; n < 8; ++n) { const bf16* s = Z + (row0 + n) * INW + colb;
                    const float x1 = bf1(s[lane]), x2 = bf1(s[lane + 64]); const float c = rope[((size_t)(LP + n) * 64 + lane) * 2], sn = rope[((size_t)(LP + n) * 64 + lane) * 2 + 1];
                    dst[lane * 8 + n] = (x1 * c - x2 * sn) * sc; dst[(lane + 64) * 8 + n] = (x1 * sn + x2 * c) * sc; }
            }
            float v[8], vs[8];
#pragma unroll
            for (int m = 0; m < 8; ++m) { v[m] = bf1(Z[(row0 + m) * INW + ZV + h * DK + e]); vs[m] = v[m] * exp2f((float)(7 - m) * l2g); }
            __syncthreads();
            {
                const int n = lane >> 3, m = lane & 7; float s = 0.f;
                for (int d = 0; d < DK; ++d) s += qT[d * 8 + n] * kT[d * 8 + m];
                scl[lane] = n >= m ? s * exp2f((float)(n - m) * l2g) : 0.f;
            }
            const float cdec = exp2f(8.0f * l2g);
            const float* S0 = a.in[2] + (size_t)bh * (DK * DK) + e; float* S1 = a.out + OUT_SS + (size_t)bh * (DK * DK) + e;
            float oa[8];
#pragma unroll
            for (int n = 0; n < 8; ++n) oa[n] = 0.f;
            for (int d0 = 0; d0 < DK; d0 += 8) {
                float s0[8];
#pragma unroll
                for (int i = 0; i < 8; ++i) s0[i] = S0[(size_t)(d0 + i) * DK];
#pragma unroll
                for (int i = 0; i < 8; ++i) { const int d = d0 + i;
                    const f32x4 q0 = *(const LAS f32x4*)(qT + d * 8), q1 = *(const LAS f32x4*)(qT + d * 8 + 4), k0 = *(const LAS f32x4*)(kT + d * 8), k1 = *(const LAS f32x4*)(kT + d * 8 + 4);
                    oa[0] += q0[0] * s0[i]; oa[1] += q0[1] * s0[i]; oa[2] += q0[2] * s0[i]; oa[3] += q0[3] * s0[i];
                    oa[4] += q1[0] * s0[i]; oa[5] += q1[1] * s0[i]; oa[6] += q1[2] * s0[i]; oa[7] += q1[3] * s0[i];
                    float sn = s0[i] * cdec;
                    sn += k0[0] * vs[0] + k0[1] * vs[1] + k0[2] * vs[2] + k0[3] * vs[3] + k1[0] * vs[4] + k1[1] * vs[5] + k1[2] * vs[6] + k1[3] * vs[7];
                    S1[(size_t)d * DK] = sn; }
            }
            float su[8], sq[8];
#pragma unroll
            for (int n = 0; n < 8; ++n) { float o = oa[n] * exp2f((float)(n + 1) * l2g);
#pragma unroll
                for (int m = 0; m < 8; ++m) if (m <= n) o += scl[n * 8 + m] * v[m];
                oa[n] = o; su[n] = wave_sum(o); sq[n] = wave_sum(o * o); }
            if (lane == 0) {
#pragma unroll
                for (int n = 0; n < 8; ++n) { part[wave * 16 + n] = su[n]; part[wave * 16 + 8 + n] = sq[n]; } }
            __syncthreads();
#pragma unroll
            for (int n = 0; n < 8; ++n) { const float s1 = su[n] + part[(wave ^ 1) * 16 + n], s2 = sq[n] + part[(wave ^ 1) * 16 + 8 + n];
                const float mean = s1 * (1.0f / DK); float var = s2 * (1.0f / DK) - mean * mean; var = var > 0.f ? var : 0.f;
                const float on = (oa[n] - mean) * (1.0f / sqrtf(var + EPS));
                const float g = bf1(Z[(row0 + n) * INW + ZG + h * DK + e]);
                CAT[(row0 + n) * D + h * DK + e] = f2bf(on * g); }
            __syncthreads();
        }
    }
    for (int m = bid * NWAVES + wave; m < MP; m += G * NWAVES) {
        float o[2][8]; vn_row(Z + (size_t)m * INW, lng, lnb, lane, o);
#pragma unroll
        for (int jj = 0; jj < 2; ++jj) { v4u w;
#pragma unroll
            for (int e = 0; e < 4; ++e) w[e] = pk2(o[jj][2 * e], o[jj][2 * e + 1]);
            *(v4u*)(VN + (size_t)m * SGW + 8 * (lane + 64 * jj)) = w; }
    }
}

__device__ __forceinline__ void p4_scan(const Args& a, int G, int bid, int tid) {
    const float* KV = (const float*)(a.ws + WS_KV); bf16* SPV = (bf16*)(a.ws + WS_SPV);
    for (int idx = bid * NTHREADS + tid; idx < BP * NH * DK * DK; idx += G * NTHREADS) {
        const int bh = idx >> 14, de = idx & 16383, h = bh & 7; const float cdec = exp2f(128.0f * log2gamma(h));
        float kv[NCH];
#pragma unroll
        for (int c = 0; c < NCH; ++c) kv[c] = KV[((size_t)bh * NCH + c) * (DK * DK) + de];
        float S = 0.f;
#pragma unroll
        for (int c = 0; c < NCH; ++c) { SPV[((size_t)bh * NCH + c) * (DK * DK) + de] = f2bf(S); S = S * cdec + kv[c]; }
        a.out[OUT_SP + idx] = S;
    }
}

__device__ __forceinline__ void p5_phase(const Args& a, LAS unsigned char* lds, int G, int bid, int tid, int wave, int lane) {
    const bf16* Z = (const bf16*)(a.ws + WS_Z); const float* rope = (const float*)(a.ws + WS_ROPE);
    const bf16* SPV = (const bf16*)(a.ws + WS_SPV); bf16* CAT = (bf16*)(a.ws + WS_CAT); const bf16* VN = (const bf16*)(a.ws + WS_VN);
    const int j = lane & 15, rq = lane >> 4;
    LAS unsigned char* t0 = lds; LAS unsigned char* t1 = lds + TILE_B; LAS unsigned char* t2 = lds + 2 * TILE_B; LAS unsigned char* t3 = lds + 3 * TILE_B;
    constexpr int NT_R = BP * NH * NCH, NT_S = BP * NCH * 8;
    const int kmax = (16 * wave + 15) >> 5;
    for (int T = bid; T < NT_R + NT_S; T += G) {
        if (T < NT_R) {
            const int c = T % NCH, h = (T / NCH) % NH, b = T / (NCH * NH);
            const size_t row0 = (size_t)b * LP + c * 128; const float l2g = log2gamma(h);
            stage_rot<false>(t0, Z + row0 * INW + ZQ + h * DK, rope + (size_t)(c * 128) * 128, 1.0f, l2g, tid);
            stage_rot<false>(t1, Z + row0 * INW + ZK + h * DK, rope + (size_t)(c * 128) * 128, 0.08838834764831845f, l2g, tid);
            stage_copy(t2, Z + row0 * INW + ZV + h * DK, INW, tid);
            stage_copy(t3, SPV + (size_t)T * (DK * DK), DK, tid);
            __syncthreads();
            f32x4 s[8];
#pragma unroll
            for (int nt = 0; nt < 8; ++nt) s[nt] = (f32x4){0.f, 0.f, 0.f, 0.f};
#pragma unroll
            for (int ks = 0; ks < 4; ++ks) { const bf16x8 aop = ld_row(t0, 16 * wave, 32 * ks, lane);
#pragma unroll
                for (int nt = 0; nt < 8; ++nt) if (nt <= wave) { const bf16x8 bop = ld_row(t1, 16 * nt, 32 * ks, lane); s[nt] = MFMA16(aop, bop, s[nt]); } }
            __syncthreads();
#pragma unroll
            for (int nt = 0; nt < 8; ++nt)
#pragma unroll
                for (int r = 0; r < 4; ++r) { const int n = 16 * wave + 4 * rq + r, mc = 16 * nt + j, dl = n - mc;
                    const float p = dl >= 0 ? s[nt][r] * exp2f((float)dl * l2g) : 0.f;
                    *(LAS bf16*)(t1 + n * RS + mc * 2) = f2bf(p); }
            asm volatile("s_waitcnt lgkmcnt(0)" ::: "memory");
            f32x4 o[8], o2[8];
            const unsigned trB_t2 = tr_base(t2, 0, lane), trB_t3 = tr_base(t3, 0, lane);
#pragma unroll
            for (int nt = 0; nt < 8; ++nt) { o[nt] = (f32x4){0.f, 0.f, 0.f, 0.f}; o2[nt] = (f32x4){0.f, 0.f, 0.f, 0.f}; }
#pragma unroll
            for (int ks = 0; ks < 4; ++ks) if (ks <= kmax) { const bf16x8 aop = ld_row(t1, 16 * wave, 32 * ks, lane);
#pragma unroll
                for (int nt = 0; nt < 8; ++nt) { const bf16x8 bop = ld_tr(trB_t2, ks * (32 * RS) + nt * 32); o[nt] = MFMA16(aop, bop, o[nt]); } }
#pragma unroll
            for (int ks = 0; ks < 4; ++ks) { const bf16x8 aop = ld_row(t0, 16 * wave, 32 * ks, lane);
#pragma unroll
                for (int nt = 0; nt < 8; ++nt) { const bf16x8 bop = ld_tr(trB_t3, ks * (32 * RS) + nt * 32); o2[nt] = MFMA16(aop, bop, o2[nt]); } }
#pragma unroll
            for (int r = 0; r < 4; ++r) { const int n = 16 * wave + 4 * rq + r; const float cr = exp2f((float)(n + 1) * l2g); float sm = 0.f;
#pragma unroll
                for (int nt = 0; nt < 8; ++nt) { o[nt][r] += o2[nt][r] * cr; sm += o[nt][r]; }
                const float mean = sum16(sm) * (1.0f / DK); float q = 0.f;
#pragma unroll
                for (int nt = 0; nt < 8; ++nt) { o[nt][r] -= mean; q += o[nt][r] * o[nt][r]; }
                const float rstd = 1.0f / sqrtf(sum16(q) * (1.0f / DK) + EPS);
#pragma unroll
                for (int nt = 0; nt < 8; ++nt) *(LAS bf16*)(t0 + n * RS + (16 * nt + j) * 2) = f2bf(o[nt][r] * rstd); }
            asm volatile("s_waitcnt lgkmcnt(0)" ::: "memory");
#pragma unroll
            for (int it = 0; it < 4; ++it) { const int idx = lane + 64 * it, rr = idx >> 4, ch = idx & 15; const size_t row = row0 + 16 * wave + rr;
                const v4u on = *(const LAS v4u*)(t0 + (16 * wave + rr) * RS + 16 * ch); const v4u g = *(const v4u*)(Z + row * INW + ZG + h * DK + 8 * ch); v4u w;
#pragma unroll
                for (int e = 0; e < 4; ++e) w[e] = pk2(bf_lo(on[e]) * bf_lo(g[e]), bf_hi(on[e]) * bf_hi(g[e]));
                *(v4u*)(CAT + row * D + h * DK + 8 * ch) = w; }
            __syncthreads();
        } else {
            const int T2 = T - NT_R; const int g = T2 & 7, c = (T2 >> 3) % NCH, b = T2 / (8 * NCH);
            const size_t row0 = (size_t)b * LP + c * 128; const float* W = a.in[12] + (size_t)g * 16384; const float* bs_ = a.in[13] + g * 128;
#pragma unroll
            for (int it = 0; it < 8; ++it) { const int idx = tid + NTHREADS * it, t = idx >> 5, s4 = (idx & 31) * 4;
                const f32x4 w = *(const f32x4*)(W + t * 128 + s4); v2u p;
                p.x = pk2(s4 <= t ? w[0] : 0.f, s4 + 1 <= t ? w[1] : 0.f); p.y = pk2(s4 + 2 <= t ? w[2] : 0.f, s4 + 3 <= t ? w[3] : 0.f);
                *(LAS v2u*)(t0 + t * RS + s4 * 2) = p; }
            stage_copy(t1, VN + row0 * SGW + g * 128, SGW, tid);
            __syncthreads();
            f32x4 acc[8];
            const unsigned trB_t1 = tr_base(t1, 0, lane);
#pragma unroll
            for (int nt = 0; nt < 8; ++nt) acc[nt] = (f32x4){0.f, 0.f, 0.f, 0.f};
#pragma unroll
            for (int ks = 0; ks < 4; ++ks) if (ks <= kmax) { const bf16x8 aop = ld_row(t0, 16 * wave, 32 * ks, lane);
#pragma unroll
                for (int nt = 0; nt < 8; ++nt) { const bf16x8 bop = ld_tr(trB_t1, ks * (32 * RS) + nt * 32); acc[nt] = MFMA16(aop, bop, acc[nt]); } }
#pragma unroll
            for (int r = 0; r < 4; ++r) { const int t = 16 * wave + 4 * rq + r; const float bias = bs_[t];
#pragma unroll
                for (int nt = 0; nt < 8; ++nt) *(LAS bf16*)(t0 + t * RS + (16 * nt + j) * 2) = f2bf(acc[nt][r] + bias); }
            asm volatile("s_waitcnt lgkmcnt(0)" ::: "memory");
#pragma unroll
            for (int it = 0; it < 4; ++it) { const int idx = lane + 64 * it, rr = idx >> 4, ch = idx & 15; const size_t row = row0 + 16 * wave + rr;
                const v4u sv = *(const LAS v4u*)(t0 + (16 * wave + rr) * RS + 16 * ch); const v4u u = *(const v4u*)(Z + row * INW + ZU + g * 128 + 8 * ch); v4u w;
#pragma unroll
                for (int e = 0; e < 4; ++e) w[e] = pk2(bf_lo(sv[e]) * bf_lo(u[e]), bf_hi(sv[e]) * bf_hi(u[e]));
                *(v4u*)(CAT + row * D + SGW + g * 128 + 8 * ch) = w; }
            __syncthreads();
        }
    }
}

constexpr int NPHASE = 11;
__global__ void __launch_bounds__(NTHREADS, 2) fwd_megakernel(Args a) {
    extern __shared__ __attribute__((aligned(16))) unsigned char lds_raw[];
    LAS unsigned char* lds = (LAS unsigned char*)lds_raw;
    cg::grid_group grid = cg::this_grid();
    const int tid = threadIdx.x, lane = tid & 63, wave = __builtin_amdgcn_readfirstlane(tid >> 6);
    const int G = gridDim.x, bid = blockIdx.x;
    const int lo = a.ph_lo, hi = a.ph_hi;
#ifndef PHMASK
#define PHMASK 0x7ff
#endif
#define IN(k) (((PHMASK >> (k)) & 1) && lo <= (k) && (k) < hi)
#define SEAM(k) do { if (IN(k) && IN((k) + 1)) grid.sync(); } while (0)
    unsigned char* ws = a.ws;
    if (IN(0)) p0_prologue(a, lds, G, bid, tid, wave, lane);
    SEAM(0);
    if (IN(1)) p1_rows(a, G, bid, wave, lane);
    SEAM(1);
    if (IN(2)) { pg8::Gemm g{(const bf16*)(ws + WS_H), (const bf16*)(ws + WS_WIN), M, INW, D}; pg8::StaticOrder S; S.init(M, INW, G, bid);
        pg8::EpiBf16<1> E{(bf16*)(ws + WS_Z), INW}; pg8::gemm_phase<pg8::EpiBf16<1>, pg8::StaticOrder, true, true>(lds, g, S, E); }
    SEAM(2);
    if (IN(3)) p3_phase(a, lds, G, bid, tid, wave, lane);
    SEAM(3);
    if (IN(4)) p4_scan(a, G, bid, tid);
    SEAM(4);
    if (IN(5)) p5_phase(a, lds, G, bid, tid, wave, lane);
    SEAM(5);
    if (IN(6)) { pg8::Gemm g{(const bf16*)(ws + WS_CAT), (const bf16*)(ws + WS_WO), M, D, D}; pg8::StaticOrder S; S.init(M, D, G, bid);
        pg8::EpiBf16<0> E{(bf16*)(ws + WS_MB), D}; pg8::gemm_phase<pg8::EpiBf16<0>, pg8::StaticOrder, true, true>(lds, g, S, E); }
    SEAM(6);
    if (IN(7)) p7_rows(a, G, bid, wave, lane);
    SEAM(7);
    if (IN(8)) { pg8::Gemm g{(const bf16*)(ws + WS_H), (const bf16*)(ws + WS_W1), M, DFF, D}; pg8::StaticOrder S; S.init(M, DFF, G, bid);
        pg8::EpiBf16<2> E{(bf16*)(ws + WS_F1), DFF}; pg8::gemm_phase<pg8::EpiBf16<2>, pg8::StaticOrder, true, true>(lds, g, S, E); }
    SEAM(8);
    if (IN(9)) { pg8::Gemm g{(const bf16*)(ws + WS_F1), (const bf16*)(ws + WS_W2), M, D, DFF}; pg8::StaticOrder S; S.init(M, D, G, bid);
        pg8::EpiBf16<0> E{(bf16*)(ws + WS_MB), D}; pg8::gemm_phase<pg8::EpiBf16<0>, pg8::StaticOrder, true, true>(lds, g, S, E); }
    SEAM(9);
    if (IN(10)) p10_rows(a, G, bid, wave, lane);
#undef IN
#undef SEAM
}

extern "C" void kernel_launch(void* const* d_in, const int* in_sizes, int n_in, void* d_out, int out_size, void* d_ws, size_t ws_size, hipStream_t stream) {
    static int grid = 0;
    if (grid == 0) {
        if (n_in != 19 || ws_size < WS_END) { fprintf(stderr, "kernel_launch: unexpected n_in %d / ws_size %zu\n", n_in, ws_size); grid = -1; return; }
        int dev = 0, cus = 0, per_cu = 0;
        hipGetDevice(&dev); hipDeviceGetAttribute(&cus, hipDeviceAttributeMultiprocessorCount, dev);
        if (hipFuncSetAttribute((const void*)fwd_megakernel, hipFuncAttributeMaxDynamicSharedMemorySize, LDS_BYTES) != hipSuccess) { fprintf(stderr, "kernel_launch: hipFuncSetAttribute failed\n"); grid = -1; return; }
        if (hipOccupancyMaxActiveBlocksPerMultiprocessor(&per_cu, (const void*)fwd_megakernel, NTHREADS, LDS_BYTES) != hipSuccess || per_cu < 1) { fprintf(stderr, "kernel_launch: occupancy query says %d\n", per_cu); per_cu = 1; }
        (void)hipGetLastError();
        grid = cus;
        fprintf(stderr, "kernel_launch: cus %d per_cu %d grid %d\n", cus, per_cu, grid);
    }
    if (grid < 0) return;
    Args a{};
    for (int i = 0; i < 19; ++i) a.in[i] = (const float*)d_in[i];
    a.out = (float*)d_out; a.ws = (unsigned char*)d_ws;
#if MK_MULTI
    for (int p = 0; p < NPHASE; ++p) { a.ph_lo = p; a.ph_hi = p + 1; void* args[] = {&a};
        hipError_t e = hipLaunchCooperativeKernel((const void*)fwd_megakernel, dim3(grid), dim3(NTHREADS), args, LDS_BYTES, stream);
        if (e != hipSuccess) { fprintf(stderr, "launch %d failed: %s\n", p, hipGetErrorString(e)); break; } }
#else
    a.ph_lo = 0; a.ph_hi = NPHASE; void* args[] = {&a};
    hipError_t e = hipLaunchCooperativeKernel((const void*)fwd_megakernel, dim3(grid), dim3(NTHREADS), args, LDS_BYTES, stream);
    if (e != hipSuccess) fprintf(stderr, "cooperative launch failed: %s (grid %d)\n", hipGetErrorString(e), grid);
#endif
}
```

```cpp
#include <hip/hip_runtime.h>
#include <hip/hip_cooperative_groups.h>
#include <cstdio>
#include <cstdint>
namespace cg = cooperative_groups;

#ifndef MK_MULTI
#define MK_MULTI 0
#endif

#define LAS __attribute__((address_space(3)))
typedef unsigned short bf16;
typedef unsigned v4u __attribute__((ext_vector_type(4)));
typedef unsigned v2u __attribute__((ext_vector_type(2)));
typedef float f32x4 __attribute__((ext_vector_type(4)));
typedef float f32x2 __attribute__((ext_vector_type(2)));
typedef short bf16x8 __attribute__((ext_vector_type(8)));
typedef short s16x4 __attribute__((ext_vector_type(4)));

namespace pg8 {
typedef unsigned short bf16_t;
typedef unsigned u32x4 __attribute__((ext_vector_type(4)));
constexpr int BM = 256, BK = 64, HALF = 128, HTB = HALF * BK * 2, STAGE_BYTES = 8 * HTB, NXCD = 8, WGM = 8;

__host__ __device__ __forceinline__ int lds_byte(int r, int c) { const int st = (r >> 4) * 2 + (c >> 5), rr = r & 15, cc = c & 31, ob = rr * 64 + cc * 2; return st * 1024 + (ob ^ (((ob >> 9) & 1) << 5)); }
__host__ __device__ __forceinline__ void stage_rc(int b, int& R, int& C) { const int st = b / 1024, sb = b % 1024, swz = sb ^ (((sb >> 9) & 1) << 5); R = (st >> 1) * 16 + swz / 64; C = (st & 1) * 32 + (swz % 64) / 2; }
__host__ __device__ __forceinline__ int perm32(int rho) { const int n = rho >> 4, i = rho & 15; return 8 * (i >> 2) + 4 * n + (i & 3); }

struct Unit { int pm, pn; };
struct Gemm { const bf16_t* A; const bf16_t* Bt; int M, N, K, ld, nNr; };

struct StaticOrder {
    int nM, nN, nwg, G, c;
    __host__ __device__ void init(int M, int N, int G_, int c_) { nM = M / BM; nN = N / BM; nwg = nM * nN; G = G_; c = c_; }
    __host__ __device__ bool next(int i, Unit& u) const {
        const long L = (long)i * G + c; if (L >= nwg) return false;
        int wgid = (int)L; { const int q = nwg / NXCD, r = nwg % NXCD, xcd = wgid % NXCD, off = wgid / NXCD; wgid = (xcd < r ? xcd * (q + 1) : r * (q + 1) + (xcd - r) * q) + off; }
        const int nig = WGM * nN, gid = wgid / nig, fm = gid * WGM, gsz = (nM - fm) < WGM ? (nM - fm) : WGM;
        u.pm = fm + ((wgid % nig) % gsz); u.pn = (wgid % nig) / gsz; return true;
    }
    __device__ __forceinline__ void a_ready(const Unit&) const {}
    __device__ __forceinline__ void done(const Unit&) const {}
};

__device__ __forceinline__ unsigned cvt_pk_bf16(float lo, float hi) { unsigned r; asm volatile("v_cvt_pk_bf16_f32 %0, %1, %2" : "=v"(r) : "v"(lo), "v"(hi)); return r; }

__device__ __forceinline__ float sigmoidf_(float y) { return __builtin_amdgcn_rcpf(1.0f + __expf(-y)); }
__device__ __forceinline__ float silu_(float x) { return x * sigmoidf_(x); }
__device__ __forceinline__ float gelu_tanh_(float x) { return x * sigmoidf_(1.5957691216057308f * (x + 0.044715f * x * x * x)); }

template <int ACT> struct EpiBf16 {
    static constexpr bool PERM = true, AFTER_DRAIN = false;
    bf16_t* O; int ldc; int nNr; size_t st1, st2, st3;
    __device__ __forceinline__ float act(float v, int sec) const {
        if (ACT == 1) { if (sec == 3) return silu_(v); if (sec >= 4) return gelu_tanh_(v); return v; }
        if (ACT == 2) { const float r = v > 0.f ? v : 0.f; return r * r; }
        return v;
    }
    __device__ __forceinline__ void operator()(const f32x4 (&acc)[2][2][4][2], const Unit& u, int wr, int wc, int fr, int fq) const {
        const int kq = u.pn / nNr; const int row0 = u.pm * BM + wr * 64 + fr; const int colt = (u.pn - kq * nNr) * BM; const int sec = colt >> 10;
        const int col0 = colt + wc * 32 + 8 * fq; bf16_t* Ob = O + (kq == 0 ? (size_t)0 : kq == 1 ? st1 : kq == 2 ? st2 : st3);
#pragma unroll
        for (int ai = 0; ai < 2; ++ai)
#pragma unroll
            for (int m = 0; m < 4; ++m) { bf16_t* rowp = Ob + (size_t)(row0 + ai * HALF + m * 16) * ldc + col0;
#pragma unroll
                for (int bj = 0; bj < 2; ++bj) { f32x4 v0 = acc[ai][bj][m][0], v1 = acc[ai][bj][m][1];
                    if (ACT != 0) {
#pragma unroll
                        for (int e = 0; e < 4; ++e) { v0[e] = act(v0[e], sec); v1[e] = act(v1[e], sec); } }
                    u32x4 w; w.x = cvt_pk_bf16(v0[0], v0[1]); w.y = cvt_pk_bf16(v0[2], v0[3]); w.z = cvt_pk_bf16(v1[0], v1[1]); w.w = cvt_pk_bf16(v1[2], v1[3]);
                    *(u32x4*)(rowp + bj * HALF) = w; } }
    }
};

template <class Epi, class Sched, bool ALIGN_EPI = false, bool SP2 = false>
__device__ __forceinline__ void gemm_phase(LAS unsigned char* lds, const Gemm g, const Sched& S, const Epi& E) {
    const int tid = threadIdx.x, wid = __builtin_amdgcn_readfirstlane(tid >> 6), lane = tid & 63, wr = wid >> 2, wc = wid & 3, fr = lane & 15, fq = lane >> 4;
    const int K = g.K, nt = K / BK;
    unsigned voffA[2], voffB[2];
#pragma unroll
    for (int i = 0; i < 2; ++i) { int R, C; stage_rc(tid * 16 + i * 8192, R, C); const int Rb = Epi::PERM ? ((R & ~31) + perm32(R & 31)) : R;
        voffA[i] = (unsigned)(R * g.ld + C) * 2u; voffB[i] = (unsigned)(Rb * g.ld + C) * 2u; }
    const size_t kstep = (size_t)(BK * 2);
    const size_t hstep = (size_t)HALF * g.ld * 2;
    const size_t tstep = 2 * hstep;
    const unsigned ldsw = (unsigned)wid * 1024u;
    const int aoff = lds_byte(wr * 64 + fr, fq * 8), boff = lds_byte(wc * 32 + fr, fq * 8);
#define PG8_SA(b, h) (((b) * 2 + (h)) * HTB)
#define PG8_SB(b, h) ((4 + (b) * 2 + (h)) * HTB)
#define PG8_STAGE(bufoff, gbase, voff) do { _Pragma("unroll") for (int _i = 0; _i < 2; ++_i) \
        __builtin_amdgcn_global_load_lds((const unsigned*)((const char*)(gbase) + (voff)[_i]), (LAS unsigned*)(lds + (bufoff) + ldsw + _i * 8192), 16, 0, 0); } while (0)
#define PG8_LDA(dst, b, h) do { _Pragma("unroll") for (int m = 0; m < 4; ++m) _Pragma("unroll") for (int k = 0; k < 2; ++k) dst[m][k] = *(const LAS bf16x8*)(lds + PG8_SA(b, h) + aoff + m * 2048 + k * 1024); } while (0)
#define PG8_LDB(dst, b, h) do { _Pragma("unroll") for (int n = 0; n < 2; ++n) _Pragma("unroll") for (int k = 0; k < 2; ++k) dst[n][k] = *(const LAS bf16x8*)(lds + PG8_SB(b, h) + boff + n * 2048 + k * 1024); } while (0)
#define PG8_MMA(ai, bj, At, Bt) do { __builtin_amdgcn_s_setprio(1); _Pragma("unroll") for (int m = 0; m < 4; ++m) _Pragma("unroll") for (int n = 0; n < 2; ++n) _Pragma("unroll") for (int k = 0; k < 2; ++k) \
        acc[ai][bj][m][n] = __builtin_amdgcn_mfma_f32_16x16x32_bf16(Bt[n][k], At[m][k], acc[ai][bj][m][n], 0, 0, 0); __builtin_amdgcn_s_setprio(0); } while (0)
#define PG8_WAIT_V(n) asm volatile("s_waitcnt vmcnt(" #n ")" ::: "memory")
#define PG8_WAIT_L(n) asm volatile("s_waitcnt lgkmcnt(" #n ")" ::: "memory")
#define PG8_BAR __builtin_amdgcn_s_barrier()
#define PG8_SCHED __builtin_amdgcn_sched_barrier(0)
    Unit cur, nxt; int ui = 0;
    if (!S.next(0, cur)) return;
    f32x4 acc[2][2][4][2];
#pragma unroll
    for (int a = 0; a < 2; ++a)
#pragma unroll
        for (int b = 0; b < 2; ++b)
#pragma unroll
            for (int m = 0; m < 4; ++m)
#pragma unroll
                for (int n = 0; n < 2; ++n) acc[a][b][m][n] = (f32x4){0.f, 0.f, 0.f, 0.f};
    bf16x8 At[4][2], B0[2][2], B1[2][2];
    #define PG8_UA(u) ((const char*)g.A + (size_t)(u).pm * tstep + (size_t)((u).pn / g.nNr) * K * 2)
#define PG8_UB(u) ((const char*)g.Bt + (size_t)((u).pn % g.nNr) * tstep + (size_t)((u).pn / g.nNr) * K * 2)
    const char* cA = PG8_UA(cur); const char* cB = PG8_UB(cur);
    S.a_ready(cur);
    if constexpr (SP2) {
        PG8_STAGE(PG8_SB(0, 0), cB, voffB); PG8_STAGE(PG8_SB(0, 1), cB + hstep, voffB); PG8_STAGE(PG8_SA(0, 0), cA, voffA); PG8_STAGE(PG8_SA(0, 1), cA + hstep, voffA);
        if (wr == 1) PG8_BAR;
        PG8_WAIT_V(2); PG8_BAR;
        PG8_STAGE(PG8_SB(1, 0), cB + kstep, voffB); PG8_STAGE(PG8_SA(1, 0), cA + kstep, voffA); PG8_STAGE(PG8_SB(1, 1), cB + hstep + kstep, voffB);
        PG8_WAIT_V(6); PG8_BAR;
    } else {
        PG8_STAGE(PG8_SB(0, 0), cB, voffB); PG8_STAGE(PG8_SA(0, 0), cA, voffA); PG8_STAGE(PG8_SB(0, 1), cB + hstep, voffB); PG8_STAGE(PG8_SA(0, 1), cA + hstep, voffA);
        if (wr == 1) PG8_BAR;
        PG8_WAIT_V(4); PG8_BAR;
        PG8_STAGE(PG8_SB(1, 0), cB + kstep, voffB); PG8_STAGE(PG8_SA(1, 0), cA + kstep, voffA); PG8_STAGE(PG8_SB(1, 1), cB + hstep + kstep, voffB);
        PG8_WAIT_V(6); PG8_BAR;
    }
    for (;;) {
        const bool has_next = S.next(ui + 1, nxt);
        const char* nA = has_next ? PG8_UA(nxt) : cA; const char* nB = has_next ? PG8_UB(nxt) : cB;
        for (int t = 0; t < nt; t += 2) {
            const bool last = (t == nt - 2);
            const char* a1 = cA + (size_t)(t + 1) * kstep;
            const char* a2 = last ? nA : cA + (size_t)(t + 2) * kstep; const char* b2 = last ? nB : cB + (size_t)(t + 2) * kstep;
            const char* a3 = a2 + kstep; const char* b3 = b2 + kstep;
            if (last && has_next) S.a_ready(nxt);
            if constexpr (SP2) {
            PG8_LDB(B0, 0, 0); PG8_LDB(B1, 0, 1); PG8_SCHED; PG8_LDA(At, 0, 0); PG8_STAGE(PG8_SA(1, 1), a1 + hstep, voffA);
            PG8_WAIT_V(8); PG8_WAIT_L(0); PG8_BAR; PG8_MMA(0, 0, At, B0); PG8_MMA(0, 1, At, B1); PG8_BAR; PG8_SCHED;
            PG8_LDA(At, 0, 1); PG8_STAGE(PG8_SB(0, 0), b2, voffB); PG8_STAGE(PG8_SB(0, 1), b2 + hstep, voffB); PG8_STAGE(PG8_SA(0, 0), a2, voffA);
            PG8_WAIT_V(8); PG8_WAIT_L(0); PG8_BAR; PG8_MMA(1, 0, At, B0); PG8_MMA(1, 1, At, B1); PG8_BAR; PG8_SCHED;
            PG8_LDB(B0, 1, 0); PG8_LDB(B1, 1, 1); PG8_SCHED; PG8_LDA(At, 1, 0); PG8_STAGE(PG8_SA(0, 1), a2 + hstep, voffA);
            PG8_WAIT_V(8); PG8_WAIT_L(0); PG8_BAR; PG8_MMA(0, 0, At, B0); PG8_MMA(0, 1, At, B1); PG8_BAR; PG8_SCHED;
            PG8_LDA(At, 1, 1); PG8_STAGE(PG8_SB(1, 0), b3, voffB); PG8_STAGE(PG8_SB(1, 1), b3 + hstep, voffB); PG8_STAGE(PG8_SA(1, 0), a3, voffA);
            PG8_WAIT_V(8); PG8_WAIT_L(0); PG8_BAR; PG8_MMA(1, 0, At, B0); PG8_MMA(1, 1, At, B1); PG8_BAR; PG8_SCHED;
            } else {
            PG8_LDB(B0, 0, 0); PG8_SCHED; PG8_LDA(At, 0, 0); PG8_STAGE(PG8_SA(1, 1), a1 + hstep, voffA);
            PG8_WAIT_L(8); PG8_BAR; PG8_WAIT_L(0); PG8_MMA(0, 0, At, B0); PG8_BAR; PG8_SCHED;
            PG8_LDB(B1, 0, 1); PG8_STAGE(PG8_SB(0, 0), b2, voffB);
            PG8_BAR; PG8_WAIT_L(0); PG8_MMA(0, 1, At, B1); PG8_BAR;
            PG8_LDA(At, 0, 1); PG8_STAGE(PG8_SA(0, 0), a2, voffA);
            PG8_BAR; PG8_WAIT_L(0); PG8_MMA(1, 0, At, B0); PG8_BAR; PG8_SCHED;
            PG8_STAGE(PG8_SB(0, 1), b2 + hstep, voffB);
            PG8_WAIT_V(6); PG8_BAR; PG8_MMA(1, 1, At, B1); PG8_BAR;
            PG8_LDB(B0, 1, 0); PG8_SCHED; PG8_LDA(At, 1, 0); PG8_STAGE(PG8_SA(0, 1), a2 + hstep, voffA);
            PG8_WAIT_L(8); PG8_BAR; PG8_WAIT_L(0); PG8_MMA(0, 0, At, B0); PG8_BAR; PG8_SCHED;
            PG8_LDB(B1, 1, 1); PG8_STAGE(PG8_SB(1, 0), b3, voffB);
            PG8_BAR; PG8_WAIT_L(0); PG8_MMA(0, 1, At, B1); PG8_BAR;
            PG8_LDA(At, 1, 1); PG8_STAGE(PG8_SA(1, 0), a3, voffA);
            PG8_BAR; PG8_WAIT_L(0); PG8_MMA(1, 0, At, B0); PG8_BAR; PG8_SCHED;
            PG8_STAGE(PG8_SB(1, 1), b3 + hstep, voffB);
            PG8_WAIT_V(6); PG8_BAR; PG8_MMA(1, 1, At, B1); PG8_BAR;
            }
        }
        if constexpr (ALIGN_EPI) { if (wr == 0) PG8_BAR; }
        if constexpr (!Epi::AFTER_DRAIN) { E(acc, cur, wr, wc, fr, fq); S.done(cur); }
        if (!has_next) break;
#pragma unroll
        for (int a = 0; a < 2; ++a)
#pragma unroll
            for (int b = 0; b < 2; ++b)
#pragma unroll
                for (int m = 0; m < 4; ++m)
#pragma unroll
                    for (int n = 0; n < 2; ++n) acc[a][b][m][n] = (f32x4){0.f, 0.f, 0.f, 0.f};
        cur = nxt; cA = nA; cB = nB; ++ui;
        if constexpr (ALIGN_EPI) { if (wr == 1) PG8_BAR; }
    }
    PG8_WAIT_V(0);
    if constexpr (!ALIGN_EPI) { if (wr == 0) PG8_BAR; }
    PG8_BAR;
#undef PG8_UA
#undef PG8_UB
#undef PG8_SA
#undef PG8_SB
#undef PG8_STAGE
#undef PG8_LDA
#undef PG8_LDB
#undef PG8_MMA
#undef PG8_WAIT_V
#undef PG8_WAIT_L
#undef PG8_BAR
#undef PG8_SCHED
}
}

constexpr int NWAVES = 8, NTHREADS = 512;
constexpr int D = 2048, MP = 8192, MS = 1024, M = MP + MS, LP = 2048, LS = 8, BP = 4, BS = 128;
constexpr int INW = 6144, DFF = 8192, NH = 8, DK = 128, SGW = 1024, NMOD = 6 * D, NMODROWS = BP + BS;
constexpr int NCH = LP / 128;
constexpr int PAST = 16384;
constexpr float EPS = 1e-6f;
constexpr int ZQ = 0, ZK = 1024, ZV = 2048, ZG = 3072, ZU = 4096, ZVS = 5120;
constexpr size_t OUT_Y = 0, OUT_SP = (size_t)M * D, OUT_SS = OUT_SP + (size_t)BP * NH * DK * DK, OUT_VN = OUT_SS + (size_t)BS * NH * DK * DK;
constexpr size_t MiB = 1u << 20;
constexpr size_t WS_WIN = 1 * MiB, WS_WO = 25 * MiB, WS_W1 = 33 * MiB, WS_W2 = 65 * MiB, WS_MOD = 97 * MiB, WS_ROPE = 104 * MiB;
constexpr size_t WS_H = 106 * MiB, WS_CAT = 142 * MiB, WS_MB = 178 * MiB, WS_VN = 214 * MiB, WS_Z = 230 * MiB, WS_KV = 338 * MiB, WS_SPV = 370 * MiB;
constexpr size_t WS_F1 = 230 * MiB, WS_P3 = 386 * MiB, WS_END = 422 * MiB;
static_assert(WS_F1 + (size_t)M * DFF * 2 <= WS_P3, "f1 overlay");
static_assert(WS_Z + (size_t)M * INW * 2 <= WS_KV, "z");
constexpr int LDS_BYTES = 147456;
constexpr int RS = 272, TILE_B = 128 * RS;
static_assert(4 * TILE_B <= LDS_BYTES, "tiles");

struct Args { const float* in[19]; float* out; unsigned char* ws; int ph_lo, ph_hi; };

__device__ __forceinline__ unsigned pk2(float lo, float hi) { return pg8::cvt_pk_bf16(lo, hi); }
__device__ __forceinline__ float bf_lo(unsigned u) { return __uint_as_float(u << 16); }
__device__ __forceinline__ float bf_hi(unsigned u) { return __uint_as_float(u & 0xffff0000u); }
__device__ __forceinline__ float bf1(bf16 b) { return __uint_as_float(((unsigned)b) << 16); }
__device__ __forceinline__ bf16 f2bf(float f) { return (bf16)(pk2(f, 0.f) & 0xffffu); }
__device__ __forceinline__ float wave_sum(float v) {
#pragma unroll
    for (int o = 1; o < 64; o <<= 1) v += __shfl_xor(v, o);
    return v;
}
__device__ __forceinline__ float sum16(float v) { v += __shfl_xor(v, 1); v += __shfl_xor(v, 2); v += __shfl_xor(v, 4); v += __shfl_xor(v, 8); return v; }
__device__ __forceinline__ float log2gamma(int h) { return log2f(1.0f - exp2f(-5.0f - (float)h)); }
__device__ __forceinline__ int modrow(int m) { return m < MP ? (m >> 11) : BP + ((m - MP) >> 3); }

__device__ __forceinline__ bf16x8 ld_row(LAS unsigned char* tile, int r0, int k0, int lane) {
    return *(const LAS bf16x8*)(tile + (r0 + (lane & 15)) * RS + (k0 + 8 * (lane >> 4)) * 2);
}
__device__ __forceinline__ unsigned tr_base(LAS unsigned char* tile, int c0, int lane) {
    const int g = lane >> 4, i = lane & 15, q = i >> 2, p = i & 3;
    return (unsigned)(uintptr_t)(tile + (8 * g + q) * RS + (c0 + 4 * p) * 2);
}
__device__ __forceinline__ bf16x8 ld_tr(unsigned base, const int OFF) {
    s16x4 lo, hi;
    asm volatile("ds_read_b64_tr_b16 %0, %2 offset:%3\n\tds_read_b64_tr_b16 %1, %2 offset:%4\n\ts_waitcnt lgkmcnt(0)" : "=&v"(lo), "=&v"(hi) : "v"(base), "n"(OFF), "n"(OFF + 4 * RS) : "memory");
    return __builtin_shufflevector(lo, hi, 0, 1, 2, 3, 4, 5, 6, 7);
}
static_assert(4 * RS == 1088, "tr offset");
#define MFMA16(a, b, c) __builtin_amdgcn_mfma_f32_16x16x32_bf16((a), (b), (c), 0, 0, 0)

__device__ __forceinline__ void stage_copy(LAS unsigned char* tile, const bf16* src, size_t stride, int tid) {
#pragma unroll
    for (int it = 0; it < 4; ++it) { const int idx = tid + NTHREADS * it, r = idx >> 4, ch = idx & 15;
        *(LAS v4u*)(tile + r * RS + 16 * ch) = *(const v4u*)(src + (size_t)r * stride + 8 * ch); }
}
template <bool SDEC>
__device__ __forceinline__ void stage_rot(LAS unsigned char* tile, const bf16* src  , const float* rope  , float scale, float l2g, int tid) {
#pragma unroll
    for (int it = 0; it < 2; ++it) {
        const int idx = tid + NTHREADS * it, r = idx >> 3, ch = idx & 7;
        const bf16* s = src + (size_t)r * INW + 8 * ch;
        const v4u x1 = *(const v4u*)s, x2 = *(const v4u*)(s + 64);
        const f32x4* cs = (const f32x4*)(rope + ((size_t)r * 64 + 8 * ch) * 2);
        const float rs = SDEC ? scale * exp2f((float)(127 - r) * l2g) : scale;
        v4u o1, o2;
#pragma unroll
        for (int e = 0; e < 4; ++e) {
            const f32x4 c = cs[e];
            const float a0 = bf_lo(x1[e]), a1 = bf_hi(x1[e]), b0 = bf_lo(x2[e]), b1 = bf_hi(x2[e]);
            o1[e] = pk2((a0 * c[0] - b0 * c[1]) * rs, (a1 * c[2] - b1 * c[3]) * rs);
            o2[e] = pk2((a0 * c[1] + b0 * c[0]) * rs, (a1 * c[3] + b1 * c[2]) * rs);
        }
        *(LAS v4u*)(tile + r * RS + 16 * ch) = o1;
        *(LAS v4u*)(tile + r * RS + 128 + 16 * ch) = o2;
    }
}

__device__ __forceinline__ void p0_transpose_item(const float* W, int K, int N, bf16* WT, LAS float* scr, int item, int lane) {
    const int nblk = N / 32, kb = item / nblk, nb = item % nblk, k0 = 64 * kb, n0 = 32 * nb;
    float tv[32];
#pragma unroll
    for (int i = 0; i < 32; ++i) tv[i] = W[(size_t)(k0 + 2 * i + (lane >> 5)) * N + n0 + (lane & 31)];
#pragma unroll
    for (int i = 0; i < 32; ++i) scr[(2 * i + (lane >> 5)) * 33 + (lane & 31)] = tv[i];
    asm volatile("s_waitcnt lgkmcnt(0)" ::: "memory");
    const int c = lane & 7;
#pragma unroll
    for (int j = 0; j < 4; ++j) { const int n = (lane >> 3) + 8 * j; const LAS float* s = scr + (8 * c) * 33 + n;
        v4u o; o.x = pk2(s[0 * 33], s[1 * 33]); o.y = pk2(s[2 * 33], s[3 * 33]); o.z = pk2(s[4 * 33], s[5 * 33]); o.w = pk2(s[6 * 33], s[7 * 33]);
        *(v4u*)(WT + (size_t)(n0 + n) * K + k0 + 8 * c) = o; }
    asm volatile("s_waitcnt lgkmcnt(0)" ::: "memory");
}

__device__ __forceinline__ void p0_mod_slab(const Args& a, LAS unsigned char* lds, int slab, int tid, int wave, int lane) {
    const float* cp = a.in[3]; const float* cs = a.in[4]; const float* wada = a.in[5]; const float* bada = a.in[6];
    float* mod = (float*)(a.ws + WS_MOD);
    LAS float* red = (LAS float*)(lds + 67584);
    const int n0 = slab * 64, j = lane & 15, kq = lane >> 4;
    f32x4 acc[9][4];
#pragma unroll
    for (int mt = 0; mt < 9; ++mt)
#pragma unroll
        for (int jj = 0; jj < 4; ++jj) acc[mt][jj] = (f32x4){0.f, 0.f, 0.f, 0.f};
    for (int ks = 0; ks < 8; ++ks) {
        const int k0 = 256 * wave + 32 * ks + 8 * kq;
        f32x4 wv[8];
#pragma unroll
        for (int i = 0; i < 8; ++i) wv[i] = *(const f32x4*)(wada + (size_t)(k0 + i) * NMOD + n0 + 4 * j);
        bf16x8 bop[4];
#pragma unroll
        for (int jj = 0; jj < 4; ++jj) { v4u w; w.x = pk2(wv[0][jj], wv[1][jj]); w.y = pk2(wv[2][jj], wv[3][jj]); w.z = pk2(wv[4][jj], wv[5][jj]); w.w = pk2(wv[6][jj], wv[7][jj]); bop[jj] = __builtin_bit_cast(bf16x8, w); }
#pragma unroll
        for (int mt = 0; mt < 9; ++mt) {
            int r = 16 * mt + j; r = r < NMODROWS ? r : NMODROWS - 1;
            const float* crow = r < BP ? cp + (size_t)r * D : cs + (size_t)(r - BP) * D;
            const f32x4 c0 = *(const f32x4*)(crow + k0), c1 = *(const f32x4*)(crow + k0 + 4);
            v4u w; w.x = pk2(pg8::silu_(c0[0]), pg8::silu_(c0[1])); w.y = pk2(pg8::silu_(c0[2]), pg8::silu_(c0[3]));
            w.z = pk2(pg8::silu_(c1[0]), pg8::silu_(c1[1])); w.w = pk2(pg8::silu_(c1[2]), pg8::silu_(c1[3]));
            const bf16x8 aop = __builtin_bit_cast(bf16x8, w);
#pragma unroll
            for (int jj = 0; jj < 4; ++jj) acc[mt][jj] = MFMA16(aop, bop[jj], acc[mt][jj]);
        }
    }
    for (int w = 0; w < 8; ++w) {
        if (wave == w) {
#pragma unroll
            for (int mt = 0; mt < 9; ++mt)
#pragma unroll
                for (int r = 0; r < 4; ++r) {
                    LAS f32x4* p = (LAS f32x4*)(red + (16 * mt + 4 * kq + r) * 64 + 4 * j);
                    f32x4 v = (f32x4){acc[mt][0][r], acc[mt][1][r], acc[mt][2][r], acc[mt][3][r]};
                    if (w) v += *p;
                    *p = v;
                }
        }
        __syncthreads();
    }
    for (int idx = tid; idx < NMODROWS * 64; idx += NTHREADS) { const int row = idx >> 6, col = idx & 63; mod[(size_t)row * NMOD + n0 + col] = red[idx] + bada[n0 + col]; }
    __syncthreads();
}

__device__ __forceinline__ void p0_prologue(const Args& a, LAS unsigned char* lds, int G, int bid, int tid, int wave, int lane) {
    for (int slab = bid; slab < NMOD / 64; slab += G) p0_mod_slab(a, lds, slab, tid, wave, lane);
    {
        float* rope = (float*)(a.ws + WS_ROPE);
        for (int idx = bid * NTHREADS + tid; idx < (LP + LS) * 64; idx += G * NTHREADS) {
            const int p = idx >> 6, jf = idx & 63; const int pos = p < LP ? p : PAST + (p - LP);
            const double inv = exp2(-(double)jf * (13.287712379549449 / 64.0));
            const double ang = (double)pos * inv;
            const double n = rint(ang * 0.15915494309189535);
            double r = fma(-n, 6.283185307179586, ang); r = fma(-n, 2.4492935982947064e-16, r);
            rope[2 * idx] = (float)cos(r); rope[2 * idx + 1] = (float)sin(r);
        }
    }
    LAS float* scr = (LAS float*)(lds + wave * 8448);
    const int gw = bid * NWAVES + wave, NGW = G * NWAVES;
    constexpr int I_IN = (D / 64) * (INW / 32);
    for (int it = gw; it < I_IN; it += NGW) p0_transpose_item(a.in[11], D, INW, (bf16*)(a.ws + WS_WIN), scr, it, lane);
}
__device__ __forceinline__ void late_transposes(const Args& a, LAS unsigned char* lds, int nb, int ib, int wave, int lane) {
    LAS float* scr = (LAS float*)(lds + wave * 8448);
    const int gw = ib * NWAVES + wave, NGW = nb * NWAVES;
    constexpr int I_O = (D / 64) * (D / 32), I_1 = (D / 64) * (DFF / 32), I_2 = (DFF / 64) * (D / 32);
    for (int it = gw; it < I_O + I_1 + I_2; it += NGW) {
        int r = it;
        if (r < I_O) { p0_transpose_item(a.in[16], D, D, (bf16*)(a.ws + WS_WO), scr, r, lane); continue; } r -= I_O;
        if (r < I_1) { p0_transpose_item(a.in[17], D, DFF, (bf16*)(a.ws + WS_W1), scr, r, lane); continue; } r -= I_1;
        p0_transpose_item(a.in[18], DFF, D, (bf16*)(a.ws + WS_W2), scr, r, lane);
    }
}

__device__ __forceinline__ const float* xrow(const Args& a, int m) { return m < MP ? a.in[0] + (size_t)m * D : a.in[1] + (size_t)(m - MP) * D; }

__device__ __forceinline__ void p1_rows(const Args& a, int G, int bid, int wave, int lane) {
    const float* mod = (const float*)(a.ws + WS_MOD); const float* g = a.in[7]; bf16* H = (bf16*)(a.ws + WS_H);
    for (int m = bid * NWAVES + wave; m < M; m += G * NWAVES) {
        const f32x4* xr = (const f32x4*)xrow(a, m) + lane; const float* md = mod + (size_t)modrow(m) * NMOD;
        f32x4 v[8]; float ss = 0.f;
#pragma unroll
        for (int j = 0; j < 8; ++j) { v[j] = xr[64 * j]; ss += (v[j][0] * v[j][0] + v[j][1] * v[j][1]) + (v[j][2] * v[j][2] + v[j][3] * v[j][3]); }
        const float rstd = 1.0f / sqrtf(wave_sum(ss) * (1.0f / D) + EPS);
#pragma unroll
        for (int j = 0; j < 8; ++j) { const int col = 4 * (lane + 64 * j);
            const f32x4 gg = *(const f32x4*)(g + col), sh = *(const f32x4*)(md + col), sc = *(const f32x4*)(md + D + col);
            const f32x4 o = v[j] * rstd * gg * (sc + 1.0f) + sh;
            v2u w; w.x = pk2(o[0], o[1]); w.y = pk2(o[2], o[3]); *(v2u*)(H + (size_t)m * D + col) = w; }
    }
}
__device__ __forceinline__ void p7_rows(const Args& a, int G, int bid, int wave, int lane) {
    const float* mod = (const float*)(a.ws + WS_MOD); const float* gpost = a.in[8]; const float* gpre = a.in[9];
    bf16* H = (bf16*)(a.ws + WS_H); const bf16* MB = (const bf16*)(a.ws + WS_MB);
    for (int m = bid * NWAVES + wave; m < M; m += G * NWAVES) {
        const f32x4* xr = (const f32x4*)xrow(a, m) + lane; const float* md = mod + (size_t)modrow(m) * NMOD;
        const v2u* mr = (const v2u*)(MB + (size_t)m * D) + lane; const v2u* mr1 = (const v2u*)((const bf16*)(a.ws + WS_Z) + (size_t)m * D) + lane;
        f32x4 v[8]; float ss = 0.f;
#pragma unroll
        for (int j = 0; j < 8; ++j) { const v2u w = mr[64 * j], w1 = mr1[64 * j]; v[j] = (f32x4){bf_lo(w.x) + bf_lo(w1.x), bf_hi(w.x) + bf_hi(w1.x), bf_lo(w.y) + bf_lo(w1.y), bf_hi(w.y) + bf_hi(w1.y)}; ss += (v[j][0] * v[j][0] + v[j][1] * v[j][1]) + (v[j][2] * v[j][2] + v[j][3] * v[j][3]); }
        const float rstd = 1.0f / sqrtf(wave_sum(ss) * (1.0f / D) + EPS);
        float s2 = 0.f;
#pragma unroll
        for (int j = 0; j < 8; ++j) { const int col = 4 * (lane + 64 * j);
            const f32x4 gg = *(const f32x4*)(gpost + col), gt = *(const f32x4*)(md + 2 * D + col);
            const f32x4 x1 = xr[64 * j] + gt * (v[j] * rstd * gg);
            v[j] = x1; s2 += (x1[0] * x1[0] + x1[1] * x1[1]) + (x1[2] * x1[2] + x1[3] * x1[3]);
            *(f32x4*)(a.out + OUT_Y + (size_t)m * D + col) = x1; }
        const float rstd2 = 1.0f / sqrtf(wave_sum(s2) * (1.0f / D) + EPS);
#pragma unroll
        for (int j = 0; j < 8; ++j) { const int col = 4 * (lane + 64 * j);
            const f32x4 gg = *(const f32x4*)(gpre + col), sh = *(const f32x4*)(md + 3 * D + col), sc = *(const f32x4*)(md + 4 * D + col);
            const f32x4 o = v[j] * rstd2 * gg * (sc + 1.0f) + sh;
            v2u w; w.x = pk2(o[0], o[1]); w.y = pk2(o[2], o[3]); *(v2u*)(H + (size_t)m * D + col) = w; }
    }
}
__device__ __forceinline__ void p10_rows(const Args& a, int G, int bid, int wave, int lane) {
    const float* mod = (const float*)(a.ws + WS_MOD); const float* gpost = a.in[10]; const bf16* MB = (const bf16*)(a.ws + WS_MB);
    for (int m = bid * NWAVES + wave; m < M; m += G * NWAVES) {
        f32x4* yr = (f32x4*)(a.out + OUT_Y + (size_t)m * D) + lane; const float* md = mod + (size_t)modrow(m) * NMOD;
        const v2u* mr = (const v2u*)(MB + (size_t)m * D) + lane; const v2u* mr1 = (const v2u*)((const bf16*)(a.ws + WS_CAT) + (size_t)m * D) + lane;
        const v2u* mr2 = (const v2u*)((const bf16*)(a.ws + WS_H) + (size_t)m * D) + lane; const v2u* mr3 = (const v2u*)((const bf16*)(a.ws + WS_P3) + (size_t)m * D) + lane;
        f32x4 v[8]; float ss = 0.f;
#pragma unroll
        for (int j = 0; j < 8; ++j) { const v2u w = mr[64 * j], w1 = mr1[64 * j], w2 = mr2[64 * j], w3 = mr3[64 * j];
            v[j] = (f32x4){(bf_lo(w.x) + bf_lo(w1.x)) + (bf_lo(w2.x) + bf_lo(w3.x)), (bf_hi(w.x) + bf_hi(w1.x)) + (bf_hi(w2.x) + bf_hi(w3.x)), (bf_lo(w.y) + bf_lo(w1.y)) + (bf_lo(w2.y) + bf_lo(w3.y)), (bf_hi(w.y) + bf_hi(w1.y)) + (bf_hi(w2.y) + bf_hi(w3.y))};
            ss += (v[j][0] * v[j][0] + v[j][1] * v[j][1]) + (v[j][2] * v[j][2] + v[j][3] * v[j][3]); }
        const float rstd = 1.0f / sqrtf(wave_sum(ss) * (1.0f / D) + EPS);
#pragma unroll
        for (int j = 0; j < 8; ++j) { const int col = 4 * (lane + 64 * j);
            const f32x4 gg = *(const f32x4*)(gpost + col), gt = *(const f32x4*)(md + 5 * D + col);
            yr[64 * j] = yr[64 * j] + gt * (v[j] * rstd * gg); }
    }
}

__device__ __forceinline__ void vn_row(const bf16* zrow, const float* lng, const float* lnb, int lane, float (&o)[2][8]) {
    float s = 0.f;
#pragma unroll
    for (int jj = 0; jj < 2; ++jj) { const v4u w = *(const v4u*)(zrow + ZVS + 8 * (lane + 64 * jj));
#pragma unroll
        for (int e = 0; e < 4; ++e) { o[jj][2 * e] = bf_lo(w[e]); o[jj][2 * e + 1] = bf_hi(w[e]); s += o[jj][2 * e] + o[jj][2 * e + 1]; } }
    const float mean = wave_sum(s) * (1.0f / SGW); float q = 0.f;
#pragma unroll
    for (int jj = 0; jj < 2; ++jj)
#pragma unroll
        for (int e = 0; e < 8; ++e) { o[jj][e] -= mean; q += o[jj][e] * o[jj][e]; }
    const float rstd = 1.0f / sqrtf(wave_sum(q) * (1.0f / SGW) + EPS);
#pragma unroll
    for (int jj = 0; jj < 2; ++jj) { const int col = 8 * (lane + 64 * jj);
#pragma unroll
        for (int e = 0; e < 8; ++e) o[jj][e] = o[jj][e] * rstd * lng[col + e] + lnb[col + e]; }
}

__device__ __forceinline__ void p3_phase(const Args& a, LAS unsigned char* lds, int G, int bid, int tid, int wave, int lane) {
    const bf16* Z = (const bf16*)(a.ws + WS_Z); const float* rope = (const float*)(a.ws + WS_ROPE);
    float* KV = (float*)(a.ws + WS_KV); bf16* CAT = (bf16*)(a.ws + WS_CAT); bf16* VN = (bf16*)(a.ws + WS_VN);
    const float* lng = a.in[14]; const float* lnb = a.in[15];
    const int j = lane & 15, rq = lane >> 4;
    LAS unsigned char* t0 = lds; LAS unsigned char* t1 = lds + TILE_B;
    constexpr int NT_KV = BP * NH * NCH, NT_SB = BS, NT_SR = BS * NH / 4;
    for (int T = bid; T < NT_KV + NT_SB + NT_SR; T += G) {
        if (T < NT_KV) {
            const int c = T % NCH, h = (T / NCH) % NH, b = T / (NCH * NH);
            const size_t row0 = (size_t)b * LP + c * 128; const float l2g = log2gamma(h);
            stage_rot<true>(t0, Z + row0 * INW + ZK + h * DK, rope + (size_t)(c * 128) * 128, 0.08838834764831845f, l2g, tid);
            stage_copy(t1, Z + row0 * INW + ZV + h * DK, INW, tid);
            __syncthreads();
            f32x4 acc[8];
            const unsigned trA = tr_base(t0, 16 * wave, lane), trB_t1 = tr_base(t1, 0, lane);
#pragma unroll
            for (int nt = 0; nt < 8; ++nt) acc[nt] = (f32x4){0.f, 0.f, 0.f, 0.f};
#pragma unroll
            for (int ks = 0; ks < 4; ++ks) { const bf16x8 aop = ld_tr(trA, ks * (32 * RS));
#pragma unroll
                for (int nt = 0; nt < 8; ++nt) { const bf16x8 bop = ld_tr(trB_t1, ks * (32 * RS) + nt * 32); acc[nt] = MFMA16(aop, bop, acc[nt]); } }
            float* kv = KV + (size_t)T * (DK * DK);
#pragma unroll
            for (int nt = 0; nt < 8; ++nt)
#pragma unroll
                for (int r = 0; r < 4; ++r) kv[(16 * wave + 4 * rq + r) * DK + 16 * nt + j] = acc[nt][r];
            __syncthreads();
        } else if (T < NT_KV + NT_SB) {
            const int b = T - NT_KV; const int row = MP + b * LS + wave; const bf16* zrow = Z + (size_t)row * INW;
            LAS float* vl = (LAS float*)lds;
            float o[2][8]; vn_row(zrow, lng, lnb, lane, o);
#pragma unroll
            for (int jj = 0; jj < 2; ++jj) { const int col = 8 * (lane + 64 * jj);
                float* dst = a.out + OUT_VN + (size_t)(b * LS + wave) * SGW + col;
                *(f32x4*)dst = (f32x4){o[jj][0], o[jj][1], o[jj][2], o[jj][3]}; *(f32x4*)(dst + 4) = (f32x4){o[jj][4], o[jj][5], o[jj][6], o[jj][7]};
                *(LAS f32x4*)(vl + wave * SGW + col) = (f32x4){o[jj][0], o[jj][1], o[jj][2], o[jj][3]}; *(LAS f32x4*)(vl + wave * SGW + col + 4) = (f32x4){o[jj][4], o[jj][5], o[jj][6], o[jj][7]}; }
            __syncthreads();
            const float* ws_ = a.in[12]; const float* bs_ = a.in[13];
#pragma unroll
            for (int jj = 0; jj < 2; ++jj) { const int col = 8 * (lane + 64 * jj), g = col >> 7;
                float s[8]; const float bias = bs_[g * 128 + wave];
#pragma unroll
                for (int e = 0; e < 8; ++e) s[e] = bias;
                for (int sp = 0; sp <= wave; ++sp) { const float w = ws_[(size_t)g * 16384 + wave * 128 + sp];
                    const f32x4 v0 = *(const LAS f32x4*)(vl + sp * SGW + col), v1 = *(const LAS f32x4*)(vl + sp * SGW + col + 4);
                    s[0] += w * v0[0]; s[1] += w * v0[1]; s[2] += w * v0[2]; s[3] += w * v0[3]; s[4] += w * v1[0]; s[5] += w * v1[1]; s[6] += w * v1[2]; s[7] += w * v1[3]; }
                const v4u u = *(const v4u*)(zrow + ZU + col); v4u w;
#pragma unroll
                for (int e = 0; e < 4; ++e) w[e] = pk2(s[2 * e] * bf_lo(u[e]), s[2 * e + 1] * bf_hi(u[e]));
                *(v4u*)(CAT + (size_t)row * D + SGW + col) = w; }
            __syncthreads();
        } else {
            const int t4 = T - NT_KV - NT_SB; const int pr = wave >> 1, eh = wave & 1; const int bh = 4 * t4 + pr, b = bh >> 3, h = bh & 7;
            const int e = 64 * eh + lane; const size_t row0 = (size_t)MP + (size_t)b * LS; const float l2g = log2gamma(h);
            LAS float* qT = (LAS float*)(lds + pr * 8192);
            LAS float* kT = (LAS float*)(lds + pr * 8192 + 4096);
            LAS float* scl = (LAS float*)(lds + 32768 + wave * 256);
            LAS float* part = (LAS float*)(lds + 36864);
            {
                const int colb = (eh ? ZK : ZQ) + h * DK; const float sc = eh ? 0.08838834764831845f : 1.0f; LAS float* dst = eh ? kT : qT;
#pragma unroll
                for (int n = 0; n < 8; ++n) { const bf16* s = Z + (row0 + n) * INW + colb;
                    const float x1 = bf1(s[lane]), x2 = bf1(s[lane + 64]); const float c = rope[((size_t)(LP + n) * 64 + lane) * 2], sn = rope[((size_t)(LP + n) * 64 + lane) * 2 + 1];
                    dst[lane * 8 + n] = (x1 * c - x2 * sn) * sc; dst[(lane + 64) * 8 + n] = (x1 * sn + x2 * c) * sc; }
            }
            float v[8], vs[8];
#pragma unroll
            for (int m = 0; m < 8; ++m) { v[m] = bf1(Z[(row0 + m) * INW + ZV + h * DK + e]); vs[m] = v[m] * exp2f((float)(7 - m) * l2g); }
            __syncthreads();
            {
                const int n = lane >> 3, m = lane & 7; float s = 0.f;
                for (int d = 0; d < DK; ++d) s += qT[d * 8 + n] * kT[d * 8 + m];
                scl[lane] = n >= m ? s * exp2f((float)(n - m) * l2g) : 0.f;
            }
            const float cdec = exp2f(8.0f * l2g);
            const float* S0 = a.in[2] + (size_t)bh * (DK * DK) + e; float* S1 = a.out + OUT_SS + (size_t)bh * (DK * DK) + e;
            float oa[8];
#pragma unroll
            for (int n = 0; n < 8; ++n) oa[n] = 0.f;
            for (int d0 = 0; d0 < DK; d0 += 8) {
                float s0[8];
#pragma unroll
                for (int i = 0; i < 8; ++i) s0[i] = S0[(size_t)(d0 + i) * DK];
#pragma unroll
                for (int i = 0; i < 8; ++i) { const int d = d0 + i;
                    const f32x4 q0 = *(const LAS f32x4*)(qT + d * 8), q1 = *(const LAS f32x4*)(qT + d * 8 + 4), k0 = *(const LAS f32x4*)(kT + d * 8), k1 = *(const LAS f32x4*)(kT + d * 8 + 4);
                    oa[0] += q0[0] * s0[i]; oa[1] += q0[1] * s0[i]; oa[2] += q0[2] * s0[i]; oa[3] += q0[3] * s0[i];
                    oa[4] += q1[0] * s0[i]; oa[5] += q1[1] * s0[i]; oa[6] += q1[2] * s0[i]; oa[7] += q1[3] * s0[i];
                    float sn = s0[i] * cdec;
                    sn += k0[0] * vs[0] + k0[1] * vs[1] + k0[2] * vs[2] + k0[3] * vs[3] + k1[0] * vs[4] + k1[1] * vs[5] + k1[2] * vs[6] + k1[3] * vs[7];
                    S1[(size_t)d * DK] = sn; }
            }
            float su[8], sq[8];
#pragma unroll
            for (int n = 0; n < 8; ++n) { float o = oa[n] * exp2f((float)(n + 1) * l2g);
#pragma unroll
                for (int m = 0; m < 8; ++m) if (m <= n) o += scl[n * 8 + m] * v[m];
                oa[n] = o; su[n] = wave_sum(o); sq[n] = wave_sum(o * o); }
            if (lane == 0) {
#pragma unroll
                for (int n = 0; n < 8; ++n) { part[wave * 16 + n] = su[n]; part[wave * 16 + 8 + n] = sq[n]; } }
            __syncthreads();
#pragma unroll
            for (int n = 0; n < 8; ++n) { const float s1 = su[n] + part[(wave ^ 1) * 16 + n], s2 = sq[n] + part[(wave ^ 1) * 16 + 8 + n];
                const float mean = s1 * (1.0f / DK); float var = s2 * (1.0f / DK) - mean * mean; var = var > 0.f ? var : 0.f;
                const float on = (oa[n] - mean) * (1.0f / sqrtf(var + EPS));
                const float g = bf1(Z[(row0 + n) * INW + ZG + h * DK + e]);
                CAT[(row0 + n) * D + h * DK + e] = f2bf(on * g); }
            __syncthreads();
        }
    }
    for (int m = bid * NWAVES + wave; m < MP; m += G * NWAVES) {
        float o[2][8]; vn_row(Z + (size_t)m * INW, lng, lnb, lane, o);
#pragma unroll
        for (int jj = 0; jj < 2; ++jj) { v4u w;
#pragma unroll
            for (int e = 0; e < 4; ++e) w[e] = pk2(o[jj][2 * e], o[jj][2 * e + 1]);
            *(v4u*)(VN + (size_t)m * SGW + 8 * (lane + 64 * jj)) = w; }
    }
}

__device__ __forceinline__ void p4_scan(const Args& a, int G, int bid, int tid) {
    const float* KV = (const float*)(a.ws + WS_KV); bf16* SPV = (bf16*)(a.ws + WS_SPV);
    for (int idx = bid * NTHREADS + tid; idx < BP * NH * DK * DK; idx += G * NTHREADS) {
        const int bh = idx >> 14, de = idx & 16383, h = bh & 7; const float cdec = exp2f(128.0f * log2gamma(h));
        float kv[NCH];
#pragma unroll
        for (int c = 0; c < NCH; ++c) kv[c] = KV[((size_t)bh * NCH + c) * (DK * DK) + de];
        float S = 0.f;
#pragma unroll
        for (int c = 0; c < NCH; ++c) { SPV[((size_t)bh * NCH + c) * (DK * DK) + de] = f2bf(S); S = S * cdec + kv[c]; }
        a.out[OUT_SP + idx] = S;
    }
}

__device__ __forceinline__ void p5_phase(const Args& a, LAS unsigned char* lds, int G, int bid, int tid, int wave, int lane) {
    const bf16* Z = (const bf16*)(a.ws + WS_Z); const float* rope = (const float*)(a.ws + WS_ROPE);
    const bf16* SPV = (const bf16*)(a.ws + WS_SPV); bf16* CAT = (bf16*)(a.ws + WS_CAT); const bf16* VN = (const bf16*)(a.ws + WS_VN);
    const int j = lane & 15, rq = lane >> 4;
    LAS unsigned char* t0 = lds; LAS unsigned char* t1 = lds + TILE_B; LAS unsigned char* t2 = lds + 2 * TILE_B; LAS unsigned char* t3 = lds + 3 * TILE_B;
    constexpr int NT_R = BP * NH * NCH, NT_S = BP * NCH * 8;
    const int kmax = (16 * wave + 15) >> 5;
    for (int T = bid; T < NT_R + NT_S; T += G) {
        if (T < NT_R) {
            const int c = T % NCH, h = (T / NCH) % NH, b = T / (NCH * NH);
            const size_t row0 = (size_t)b * LP + c * 128; const float l2g = log2gamma(h);
            stage_rot<false>(t0, Z + row0 * INW + ZQ + h * DK, rope + (size_t)(c * 128) * 128, 1.0f, l2g, tid);
            stage_rot<false>(t1, Z + row0 * INW + ZK + h * DK, rope + (size_t)(c * 128) * 128, 0.08838834764831845f, l2g, tid);
            stage_copy(t2, Z + row0 * INW + ZV + h * DK, INW, tid);
            stage_copy(t3, SPV + (size_t)T * (DK * DK), DK, tid);
            __syncthreads();
            f32x4 s[8];
#pragma unroll
            for (int nt = 0; nt < 8; ++nt) s[nt] = (f32x4){0.f, 0.f, 0.f, 0.f};
#pragma unroll
            for (int ks = 0; ks < 4; ++ks) { const bf16x8 aop = ld_row(t0, 16 * wave, 32 * ks, lane);
#pragma unroll
                for (int nt = 0; nt < 8; ++nt) if (nt <= wave) { const bf16x8 bop = ld_row(t1, 16 * nt, 32 * ks, lane); s[nt] = MFMA16(aop, bop, s[nt]); } }
            __syncthreads();
#pragma unroll
            for (int nt = 0; nt < 8; ++nt)
#pragma unroll
                for (int r = 0; r < 4; ++r) { const int n = 16 * wave + 4 * rq + r, mc = 16 * nt + j, dl = n - mc;
                    const float p = dl >= 0 ? s[nt][r] * exp2f((float)dl * l2g) : 0.f;
                    *(LAS bf16*)(t1 + n * RS + mc * 2) = f2bf(p); }
            asm volatile("s_waitcnt lgkmcnt(0)" ::: "memory");
            f32x4 o[8], o2[8];
            const unsigned trB_t2 = tr_base(t2, 0, lane), trB_t3 = tr_base(t3, 0, lane);
#pragma unroll
            for (int nt = 0; nt < 8; ++nt) { o[nt] = (f32x4){0.f, 0.f, 0.f, 0.f}; o2[nt] = (f32x4){0.f, 0.f, 0.f, 0.f}; }
#pragma unroll
            for (int ks = 0; ks < 4; ++ks) if (ks <= kmax) { const bf16x8 aop = ld_row(t1, 16 * wave, 32 * ks, lane);
#pragma unroll
                for (int nt = 0; nt < 8; ++nt) { const bf16x8 bop = ld_tr(trB_t2, ks * (32 * RS) + nt * 32); o[nt] = MFMA16(aop, bop, o[nt]); } }
#pragma unroll
            for (int ks = 0; ks < 4; ++ks) { const bf16x8 aop = ld_row(t0, 16 * wave, 32 * ks, lane);
#pragma unroll
                for (int nt = 0; nt < 8; ++nt) { const bf16x8 bop = ld_tr(trB_t3, ks * (32 * RS) + nt * 32); o2[nt] = MFMA16(aop, bop, o2[nt]); } }
#pragma unroll
            for (int r = 0; r < 4; ++r) { const int n = 16 * wave + 4 * rq + r; const float cr = exp2f((float)(n + 1) * l2g); float sm = 0.f;
#pragma unroll
                for (int nt = 0; nt < 8; ++nt) { o[nt][r] += o2[nt][r] * cr; sm += o[nt][r]; }
                const float mean = sum16(sm) * (1.0f / DK); float q = 0.f;
#pragma unroll
                for (int nt = 0; nt < 8; ++nt) { o[nt][r] -= mean; q += o[nt][r] * o[nt][r]; }
                const float rstd = 1.0f / sqrtf(sum16(q) * (1.0f / DK) + EPS);
#pragma unroll
                for (int nt = 0; nt < 8; ++nt) *(LAS bf16*)(t0 + n * RS + (16 * nt + j) * 2) = f2bf(o[nt][r] * rstd); }
            asm volatile("s_waitcnt lgkmcnt(0)" ::: "memory");
#pragma unroll
            for (int it = 0; it < 4; ++it) { const int idx = lane + 64 * it, rr = idx >> 4, ch = idx & 15; const size_t row = row0 + 16 * wave + rr;
                const v4u on = *(const LAS v4u*)(t0 + (16 * wave + rr) * RS + 16 * ch); const v4u g = *(const v4u*)(Z + row * INW + ZG + h * DK + 8 * ch); v4u w;
#pragma unroll
                for (int e = 0; e < 4; ++e) w[e] = pk2(bf_lo(on[e]) * bf_lo(g[e]), bf_hi(on[e]) * bf_hi(g[e]));
                *(v4u*)(CAT + row * D + h * DK + 8 * ch) = w; }
            __syncthreads();
        } else {
            const int T2 = T - NT_R; const int g = T2 & 7, c = (T2 >> 3) % NCH, b = T2 / (8 * NCH);
            const size_t row0 = (size_t)b * LP + c * 128; const float* W = a.in[12] + (size_t)g * 16384; const float* bs_ = a.in[13] + g * 128;
#pragma unroll
            for (int it = 0; it < 8; ++it) { const int idx = tid + NTHREADS * it, t = idx >> 5, s4 = (idx & 31) * 4;
                const f32x4 w = *(const f32x4*)(W + t * 128 + s4); v2u p;
                p.x = pk2(s4 <= t ? w[0] : 0.f, s4 + 1 <= t ? w[1] : 0.f); p.y = pk2(s4 + 2 <= t ? w[2] : 0.f, s4 + 3 <= t ? w[3] : 0.f);
                *(LAS v2u*)(t0 + t * RS + s4 * 2) = p; }
            stage_copy(t1, VN + row0 * SGW + g * 128, SGW, tid);
            __syncthreads();
            f32x4 acc[8];
            const unsigned trB_t1 = tr_base(t1, 0, lane);
#pragma unroll
            for (int nt = 0; nt < 8; ++nt) acc[nt] = (f32x4){0.f, 0.f, 0.f, 0.f};
#pragma unroll
            for (int ks = 0; ks < 4; ++ks) if (ks <= kmax) { const bf16x8 aop = ld_row(t0, 16 * wave, 32 * ks, lane);
#pragma unroll
                for (int nt = 0; nt < 8; ++nt) { const bf16x8 bop = ld_tr(trB_t1, ks * (32 * RS) + nt * 32); acc[nt] = MFMA16(aop, bop, acc[nt]); } }
#pragma unroll
            for (int r = 0; r < 4; ++r) { const int t = 16 * wave + 4 * rq + r; const float bias = bs_[t];
#pragma unroll
                for (int nt = 0; nt < 8; ++nt) *(LAS bf16*)(t0 + t * RS + (16 * nt + j) * 2) = f2bf(acc[nt][r] + bias); }
            asm volatile("s_waitcnt lgkmcnt(0)" ::: "memory");
#pragma unroll
            for (int it = 0; it < 4; ++it) { const int idx = lane + 64 * it, rr = idx >> 4, ch = idx & 15; const size_t row = row0 + 16 * wave + rr;
                const v4u sv = *(const LAS v4u*)(t0 + (16 * wave + rr) * RS + 16 * ch); const v4u u = *(const v4u*)(Z + row * INW + ZU + g * 128 + 8 * ch); v4u w;
#pragma unroll
                for (int e = 0; e < 4; ++e) w[e] = pk2(bf_lo(sv[e]) * bf_lo(u[e]), bf_hi(sv[e]) * bf_hi(u[e]));
                *(v4u*)(CAT + row * D + SGW + g * 128 + 8 * ch) = w; }
            __syncthreads();
        }
    }
}

constexpr int NPHASE = 11;
__global__ void __launch_bounds__(NTHREADS, 2) fwd_megakernel(Args a) {
    extern __shared__ __attribute__((aligned(16))) unsigned char lds_raw[];
    LAS unsigned char* lds = (LAS unsigned char*)lds_raw;
    cg::grid_group grid = cg::this_grid();
    const int tid = threadIdx.x, lane = tid & 63, wave = __builtin_amdgcn_readfirstlane(tid >> 6);
    const int G = gridDim.x, bid = blockIdx.x;
    const int lo = a.ph_lo, hi = a.ph_hi;
#ifndef PHMASK
#define PHMASK 0x7ff
#endif
#define IN(k) (((PHMASK >> (k)) & 1) && lo <= (k) && (k) < hi)
#define SEAM(k) do { if (IN(k) && IN((k) + 1)) grid.sync(); } while (0)
    unsigned char* ws = a.ws;
    if (IN(0)) p0_prologue(a, lds, G, bid, tid, wave, lane);
    SEAM(0);
    if (IN(1)) p1_rows(a, G, bid, wave, lane);
    SEAM(1);
    if (IN(2)) { pg8::Gemm g{(const bf16*)(ws + WS_H), (const bf16*)(ws + WS_WIN), M, INW, D, D, INW / 256}; pg8::StaticOrder S; S.init(M, INW, G, bid);
        pg8::EpiBf16<1> E{(bf16*)(ws + WS_Z), INW, INW / 256, 0, 0, 0}; pg8::gemm_phase<pg8::EpiBf16<1>, pg8::StaticOrder, true, true>(lds, g, S, E);
        const int nun = (M / 256) * (INW / 256), rem = nun % G;
        if (rem == 0) late_transposes(a, lds, G, bid, wave, lane); else if (bid >= rem) late_transposes(a, lds, G - rem, bid - rem, wave, lane); }
    SEAM(2);
    if (IN(3)) p3_phase(a, lds, G, bid, tid, wave, lane);
    SEAM(3);
    if (IN(4)) p4_scan(a, G, bid, tid);
    SEAM(4);
    if (IN(5)) p5_phase(a, lds, G, bid, tid, wave, lane);
    SEAM(5);
    if (IN(6)) { pg8::Gemm g{(const bf16*)(ws + WS_CAT), (const bf16*)(ws + WS_WO), M, D, D / 2, D, D / 256}; pg8::StaticOrder S; S.init(M, 2 * D, G, bid);
        pg8::EpiBf16<0> E{(bf16*)(ws + WS_MB), D, D / 256, (WS_Z - WS_MB) / 2, 0, 0}; pg8::gemm_phase<pg8::EpiBf16<0>, pg8::StaticOrder, true, true>(lds, g, S, E); }
    SEAM(6);
    if (IN(7)) p7_rows(a, G, bid, wave, lane);
    SEAM(7);
    if (IN(8)) { pg8::Gemm g{(const bf16*)(ws + WS_H), (const bf16*)(ws + WS_W1), M, DFF, D, D, DFF / 256}; pg8::StaticOrder S; S.init(M, DFF, G, bid);
        pg8::EpiBf16<2> E{(bf16*)(ws + WS_F1), DFF, DFF / 256, 0, 0, 0}; pg8::gemm_phase<pg8::EpiBf16<2>, pg8::StaticOrder, true, true>(lds, g, S, E); }
    SEAM(8);
    if (IN(9)) { pg8::Gemm g{(const bf16*)(ws + WS_F1), (const bf16*)(ws + WS_W2), M, D, DFF / 4, DFF, D / 256}; pg8::StaticOrder S; S.init(M, 4 * D, G, bid);
        pg8::EpiBf16<0> E{(bf16*)(ws + WS_MB), D, D / 256, (size_t)0 - (WS_MB - WS_CAT) / 2, (size_t)0 - (WS_MB - WS_H) / 2, (WS_P3 - WS_MB) / 2}; pg8::gemm_phase<pg8::EpiBf16<0>, pg8::StaticOrder, true, true>(lds, g, S, E); }
    SEAM(9);
    if (IN(10)) p10_rows(a, G, bid, wave, lane);
#undef IN
#undef SEAM
}

extern "C" void kernel_launch(void* const* d_in, const int* in_sizes, int n_in, void* d_out, int out_size, void* d_ws, size_t ws_size, hipStream_t stream) {
    static int grid = 0;
    if (grid == 0) {
        if (n_in != 19 || ws_size < WS_END) { fprintf(stderr, "kernel_launch: unexpected n_in %d / ws_size %zu\n", n_in, ws_size); grid = -1; return; }
        int dev = 0, cus = 0, per_cu = 0;
        hipGetDevice(&dev); hipDeviceGetAttribute(&cus, hipDeviceAttributeMultiprocessorCount, dev);
        if (hipFuncSetAttribute((const void*)fwd_megakernel, hipFuncAttributeMaxDynamicSharedMemorySize, LDS_BYTES) != hipSuccess) { fprintf(stderr, "kernel_launch: hipFuncSetAttribute failed\n"); grid = -1; return; }
        if (hipOccupancyMaxActiveBlocksPerMultiprocessor(&per_cu, (const void*)fwd_megakernel, NTHREADS, LDS_BYTES) != hipSuccess || per_cu < 1) { fprintf(stderr, "kernel_launch: occupancy query says %d\n", per_cu); per_cu = 1; }
        (void)hipGetLastError();
        grid = cus;
        fprintf(stderr, "kernel_launch: cus %d per_cu %d grid %d\n", cus, per_cu, grid);
    }
    if (grid < 0) return;
    Args a{};
    for (int i = 0; i < 19; ++i) a.in[i] = (const float*)d_in[i];
    a.out = (float*)d_out; a.ws = (unsigned char*)d_ws;
#if MK_MULTI
    for (int p = 0; p < NPHASE; ++p) { a.ph_lo = p; a.ph_hi = p + 1; void* args[] = {&a};
        hipError_t e = hipLaunchCooperativeKernel((const void*)fwd_megakernel, dim3(grid), dim3(NTHREADS), args, LDS_BYTES, stream);
        if (e != hipSuccess) { fprintf(stderr, "launch %d failed: %s\n", p, hipGetErrorString(e)); break; } }
#else
    a.ph_lo = 0; a.ph_hi = NPHASE; void* args[] = {&a};
    hipError_t e = hipLaunchCooperativeKernel((const void*)fwd_megakernel, dim3(grid), dim3(NTHREADS), args, LDS_BYTES, stream);
    if (e != hipSuccess) fprintf(stderr, "cooperative launch failed: %s (grid %d)\n", hipGetErrorString(e), grid);
#endif
}
```

```cpp
#include <hip/hip_runtime.h>
#include <hip/hip_cooperative_groups.h>
#include <cstdio>
#include <cstdint>
namespace cg = cooperative_groups;

#ifndef MK_MULTI
#define MK_MULTI 0
#endif

#define LAS __attribute__((address_space(3)))
typedef unsigned short bf16;
typedef unsigned v4u __attribute__((ext_vector_type(4)));
typedef unsigned v2u __attribute__((ext_vector_type(2)));
typedef float f32x4 __attribute__((ext_vector_type(4)));
typedef float f32x2 __attribute__((ext_vector_type(2)));
typedef short bf16x8 __attribute__((ext_vector_type(8)));
typedef short s16x4 __attribute__((ext_vector_type(4)));

namespace pg8 {
typedef unsigned short bf16_t;
typedef unsigned u32x4 __attribute__((ext_vector_type(4)));
constexpr int BM = 256, BK = 64, HALF = 128, HTB = HALF * BK * 2, STAGE_BYTES = 8 * HTB, NXCD = 8, WGM = 8;

__host__ __device__ __forceinline__ int lds_byte(int r, int c) { const int st = (r >> 4) * 2 + (c >> 5), rr = r & 15, cc = c & 31, ob = rr * 64 + cc * 2; return st * 1024 + (ob ^ (((ob >> 9) & 1) << 5)); }
__host__ __device__ __forceinline__ void stage_rc(int b, int& R, int& C) { const int st = b / 1024, sb = b % 1024, swz = sb ^ (((sb >> 9) & 1) << 5); R = (st >> 1) * 16 + swz / 64; C = (st & 1) * 32 + (swz % 64) / 2; }
__host__ __device__ __forceinline__ int perm32(int rho) { const int n = rho >> 4, i = rho & 15; return 8 * (i >> 2) + 4 * n + (i & 3); }

struct Unit { int pm, pn; };
struct Gemm { const bf16_t* A; const bf16_t* Bt; int M, N, K, ld, nNr; };

struct StaticOrder {
    int nM, nN, nwg, G, c;
    __host__ __device__ void init(int M, int N, int G_, int c_) { nM = M / BM; nN = N / BM; nwg = nM * nN; G = G_; c = c_; }
    __host__ __device__ bool next(int i, Unit& u) const {
        const long L = (long)i * G + c; if (L >= nwg) return false;
        int wgid = (int)L; { const int q = nwg / NXCD, r = nwg % NXCD, xcd = wgid % NXCD, off = wgid / NXCD; wgid = (xcd < r ? xcd * (q + 1) : r * (q + 1) + (xcd - r) * q) + off; }
        const int nig = WGM * nN, gid = wgid / nig, fm = gid * WGM, gsz = (nM - fm) < WGM ? (nM - fm) : WGM;
        u.pm = fm + ((wgid % nig) % gsz); u.pn = (wgid % nig) / gsz; return true;
    }
    __device__ __forceinline__ void a_ready(const Unit&) const {}
    __device__ __forceinline__ void done(const Unit&) const {}
};

__device__ __forceinline__ unsigned cvt_pk_bf16(float lo, float hi) { unsigned r; asm volatile("v_cvt_pk_bf16_f32 %0, %1, %2" : "=v"(r) : "v"(lo), "v"(hi)); return r; }

__device__ __forceinline__ float sigmoidf_(float y) { return __builtin_amdgcn_rcpf(1.0f + __expf(-y)); }
__device__ __forceinline__ float silu_(float x) { return x * sigmoidf_(x); }
__device__ __forceinline__ float gelu_tanh_(float x) { return x * sigmoidf_(1.5957691216057308f * (x + 0.044715f * x * x * x)); }

template <int ACT> struct EpiBf16 {
    static constexpr bool PERM = true, AFTER_DRAIN = false;
    bf16_t* O; int ldc; int nNr; size_t st1, st2, st3;
    __device__ __forceinline__ float act(float v, int sec) const {
        if (ACT == 1) { if (sec == 3) return silu_(v); if (sec >= 4) return gelu_tanh_(v); return v; }
        if (ACT == 2) { const float r = v > 0.f ? v : 0.f; return r * r; }
        return v;
    }
    __device__ __forceinline__ void operator()(const f32x4 (&acc)[2][2][4][2], const Unit& u, int wr, int wc, int fr, int fq) const {
        const int kq = u.pn / nNr; const int row0 = u.pm * BM + wr * 64 + fr; const int colt = (u.pn - kq * nNr) * BM; const int sec = colt >> 10;
        const int col0 = colt + wc * 32 + 8 * fq; bf16_t* Ob = O + (kq == 0 ? (size_t)0 : kq == 1 ? st1 : kq == 2 ? st2 : st3);
#pragma unroll
        for (int ai = 0; ai < 2; ++ai)
#pragma unroll
            for (int m = 0; m < 4; ++m) { bf16_t* rowp = Ob + (size_t)(row0 + ai * HALF + m * 16) * ldc + col0;
#pragma unroll
                for (int bj = 0; bj < 2; ++bj) { f32x4 v0 = acc[ai][bj][m][0], v1 = acc[ai][bj][m][1];
                    if (ACT != 0) {
#pragma unroll
                        for (int e = 0; e < 4; ++e) { v0[e] = act(v0[e], sec); v1[e] = act(v1[e], sec); } }
                    u32x4 w; w.x = cvt_pk_bf16(v0[0], v0[1]); w.y = cvt_pk_bf16(v0[2], v0[3]); w.z = cvt_pk_bf16(v1[0], v1[1]); w.w = cvt_pk_bf16(v1[2], v1[3]);
                    *(u32x4*)(rowp + bj * HALF) = w; } }
    }
};

template <class Epi, class Sched, bool ALIGN_EPI = false, bool SP2 = false>
__device__ __forceinline__ void gemm_phase(LAS unsigned char* lds, const Gemm g, const Sched& S, const Epi& E) {
    const int tid = threadIdx.x, wid = __builtin_amdgcn_readfirstlane(tid >> 6), lane = tid & 63, wr = wid >> 2, wc = wid & 3, fr = lane & 15, fq = lane >> 4;
    const int K = g.K, nt = K / BK;
    unsigned voffA[2], voffB[2];
#pragma unroll
    for (int i = 0; i < 2; ++i) { int R, C; stage_rc(tid * 16 + i * 8192, R, C); const int Rb = Epi::PERM ? ((R & ~31) + perm32(R & 31)) : R;
        voffA[i] = (unsigned)(R * g.ld + C) * 2u; voffB[i] = (unsigned)(Rb * g.ld + C) * 2u; }
    const size_t kstep = (size_t)(BK * 2);
    const size_t hstep = (size_t)HALF * g.ld * 2;
    const size_t tstep = 2 * hstep;
    const unsigned ldsw = (unsigned)wid * 1024u;
    const int aoff = lds_byte(wr * 64 + fr, fq * 8), boff = lds_byte(wc * 32 + fr, fq * 8);
#define PG8_SA(b, h) (((b) * 2 + (h)) * HTB)
#define PG8_SB(b, h) ((4 + (b) * 2 + (h)) * HTB)
#define PG8_STAGE(bufoff, gbase, voff) do { _Pragma("unroll") for (int _i = 0; _i < 2; ++_i) \
        __builtin_amdgcn_global_load_lds((const unsigned*)((const char*)(gbase) + (voff)[_i]), (LAS unsigned*)(lds + (bufoff) + ldsw + _i * 8192), 16, 0, 0); } while (0)
#define PG8_LDA(dst, b, h) do { _Pragma("unroll") for (int m = 0; m < 4; ++m) _Pragma("unroll") for (int k = 0; k < 2; ++k) dst[m][k] = *(const LAS bf16x8*)(lds + PG8_SA(b, h) + aoff + m * 2048 + k * 1024); } while (0)
#define PG8_LDB(dst, b, h) do { _Pragma("unroll") for (int n = 0; n < 2; ++n) _Pragma("unroll") for (int k = 0; k < 2; ++k) dst[n][k] = *(const LAS bf16x8*)(lds + PG8_SB(b, h) + boff + n * 2048 + k * 1024); } while (0)
#define PG8_MMA(ai, bj, At, Bt) do { __builtin_amdgcn_s_setprio(1); _Pragma("unroll") for (int m = 0; m < 4; ++m) _Pragma("unroll") for (int n = 0; n < 2; ++n) _Pragma("unroll") for (int k = 0; k < 2; ++k) \
        acc[ai][bj][m][n] = __builtin_amdgcn_mfma_f32_16x16x32_bf16(Bt[n][k], At[m][k], acc[ai][bj][m][n], 0, 0, 0); __builtin_amdgcn_s_setprio(0); } while (0)
#define PG8_WAIT_V(n) asm volatile("s_waitcnt vmcnt(" #n ")" ::: "memory")
#define PG8_WAIT_L(n) asm volatile("s_waitcnt lgkmcnt(" #n ")" ::: "memory")
#define PG8_BAR __builtin_amdgcn_s_barrier()
#define PG8_SCHED __builtin_amdgcn_sched_barrier(0)
    Unit cur, nxt; int ui = 0;
    if (!S.next(0, cur)) return;
    f32x4 acc[2][2][4][2];
#pragma unroll
    for (int a = 0; a < 2; ++a)
#pragma unroll
        for (int b = 0; b < 2; ++b)
#pragma unroll
            for (int m = 0; m < 4; ++m)
#pragma unroll
                for (int n = 0; n < 2; ++n) acc[a][b][m][n] = (f32x4){0.f, 0.f, 0.f, 0.f};
    bf16x8 At[4][2], B0[2][2], B1[2][2];
    #define PG8_UA(u) ((const char*)g.A + (size_t)(u).pm * tstep + (size_t)((u).pn / g.nNr) * K * 2)
#define PG8_UB(u) ((const char*)g.Bt + (size_t)((u).pn % g.nNr) * tstep + (size_t)((u).pn / g.nNr) * K * 2)
    const char* cA = PG8_UA(cur); const char* cB = PG8_UB(cur);
    S.a_ready(cur);
    if constexpr (SP2) {
        PG8_STAGE(PG8_SB(0, 0), cB, voffB); PG8_STAGE(PG8_SB(0, 1), cB + hstep, voffB); PG8_STAGE(PG8_SA(0, 0), cA, voffA); PG8_STAGE(PG8_SA(0, 1), cA + hstep, voffA);
        if (wr == 1) PG8_BAR;
        PG8_WAIT_V(2); PG8_BAR;
        PG8_STAGE(PG8_SB(1, 0), cB + kstep, voffB); PG8_STAGE(PG8_SA(1, 0), cA + kstep, voffA); PG8_STAGE(PG8_SB(1, 1), cB + hstep + kstep, voffB);
        PG8_WAIT_V(6); PG8_BAR;
    } else {
        PG8_STAGE(PG8_SB(0, 0), cB, voffB); PG8_STAGE(PG8_SA(0, 0), cA, voffA); PG8_STAGE(PG8_SB(0, 1), cB + hstep, voffB); PG8_STAGE(PG8_SA(0, 1), cA + hstep, voffA);
        if (wr == 1) PG8_BAR;
        PG8_WAIT_V(4); PG8_BAR;
        PG8_STAGE(PG8_SB(1, 0), cB + kstep, voffB); PG8_STAGE(PG8_SA(1, 0), cA + kstep, voffA); PG8_STAGE(PG8_SB(1, 1), cB + hstep + kstep, voffB);
        PG8_WAIT_V(6); PG8_BAR;
    }
    for (;;) {
        const bool has_next = S.next(ui + 1, nxt);
        const char* nA = has_next ? PG8_UA(nxt) : cA; const char* nB = has_next ? PG8_UB(nxt) : cB;
        for (int t = 0; t < nt; t += 2) {
            const bool last = (t == nt - 2);
            const char* a1 = cA + (size_t)(t + 1) * kstep;
            const char* a2 = last ? nA : cA + (size_t)(t + 2) * kstep; const char* b2 = last ? nB : cB + (size_t)(t + 2) * kstep;
            const char* a3 = a2 + kstep; const char* b3 = b2 + kstep;
            if (last && has_next) S.a_ready(nxt);
            if constexpr (SP2) {
            PG8_LDB(B0, 0, 0); PG8_LDB(B1, 0, 1); PG8_SCHED; PG8_LDA(At, 0, 0); PG8_STAGE(PG8_SA(1, 1), a1 + hstep, voffA);
            PG8_WAIT_V(8); PG8_WAIT_L(0); PG8_BAR; PG8_MMA(0, 0, At, B0); PG8_MMA(0, 1, At, B1); PG8_BAR; PG8_SCHED;
            PG8_LDA(At, 0, 1); PG8_STAGE(PG8_SB(0, 0), b2, voffB); PG8_STAGE(PG8_SB(0, 1), b2 + hstep, voffB); PG8_STAGE(PG8_SA(0, 0), a2, voffA);
            PG8_WAIT_V(8); PG8_WAIT_L(0); PG8_BAR; PG8_MMA(1, 0, At, B0); PG8_MMA(1, 1, At, B1); PG8_BAR; PG8_SCHED;
            PG8_LDB(B0, 1, 0); PG8_LDB(B1, 1, 1); PG8_SCHED; PG8_LDA(At, 1, 0); PG8_STAGE(PG8_SA(0, 1), a2 + hstep, voffA);
            PG8_WAIT_V(8); PG8_WAIT_L(0); PG8_BAR; PG8_MMA(0, 0, At, B0); PG8_MMA(0, 1, At, B1); PG8_BAR; PG8_SCHED;
            PG8_LDA(At, 1, 1); PG8_STAGE(PG8_SB(1, 0), b3, voffB); PG8_STAGE(PG8_SB(1, 1), b3 + hstep, voffB); PG8_STAGE(PG8_SA(1, 0), a3, voffA);
            PG8_WAIT_V(8); PG8_WAIT_L(0); PG8_BAR; PG8_MMA(1, 0, At, B0); PG8_MMA(1, 1, At, B1); PG8_BAR; PG8_SCHED;
            } else {
            PG8_LDB(B0, 0, 0); PG8_SCHED; PG8_LDA(At, 0, 0); PG8_STAGE(PG8_SA(1, 1), a1 + hstep, voffA);
            PG8_WAIT_L(8); PG8_BAR; PG8_WAIT_L(0); PG8_MMA(0, 0, At, B0); PG8_BAR; PG8_SCHED;
            PG8_LDB(B1, 0, 1); PG8_STAGE(PG8_SB(0, 0), b2, voffB);
            PG8_BAR; PG8_WAIT_L(0); PG8_MMA(0, 1, At, B1); PG8_BAR;
            PG8_LDA(At, 0, 1); PG8_STAGE(PG8_SA(0, 0), a2, voffA);
            PG8_BAR; PG8_WAIT_L(0); PG8_MMA(1, 0, At, B0); PG8_BAR; PG8_SCHED;
            PG8_STAGE(PG8_SB(0, 1), b2 + hstep, voffB);
            PG8_WAIT_V(6); PG8_BAR; PG8_MMA(1, 1, At, B1); PG8_BAR;
            PG8_LDB(B0, 1, 0); PG8_SCHED; PG8_LDA(At, 1, 0); PG8_STAGE(PG8_SA(0, 1), a2 + hstep, voffA);
            PG8_WAIT_L(8); PG8_BAR; PG8_WAIT_L(0); PG8_MMA(0, 0, At, B0); PG8_BAR; PG8_SCHED;
            PG8_LDB(B1, 1, 1); PG8_STAGE(PG8_SB(1, 0), b3, voffB);
            PG8_BAR; PG8_WAIT_L(0); PG8_MMA(0, 1, At, B1); PG8_BAR;
            PG8_LDA(At, 1, 1); PG8_STAGE(PG8_SA(1, 0), a3, voffA);
            PG8_BAR; PG8_WAIT_L(0); PG8_MMA(1, 0, At, B0); PG8_BAR; PG8_SCHED;
            PG8_STAGE(PG8_SB(1, 1), b3 + hstep, voffB);
            PG8_WAIT_V(6); PG8_BAR; PG8_MMA(1, 1, At, B1); PG8_BAR;
            }
        }
        if constexpr (ALIGN_EPI) { if (wr == 0) PG8_BAR; }
        if constexpr (!Epi::AFTER_DRAIN) { E(acc, cur, wr, wc, fr, fq); S.done(cur); }
        if (!has_next) break;
#pragma unroll
        for (int a = 0; a < 2; ++a)
#pragma unroll
            for (int b = 0; b < 2; ++b)
#pragma unroll
                for (int m = 0; m < 4; ++m)
#pragma unroll
                    for (int n = 0; n < 2; ++n) acc[a][b][m][n] = (f32x4){0.f, 0.f, 0.f, 0.f};
        cur = nxt; cA = nA; cB = nB; ++ui;
        if constexpr (ALIGN_EPI) { if (wr == 1) PG8_BAR; }
    }
    PG8_WAIT_V(0);
    if constexpr (!ALIGN_EPI) { if (wr == 0) PG8_BAR; }
    PG8_BAR;
#undef PG8_UA
#undef PG8_UB
#undef PG8_SA
#undef PG8_SB
#undef PG8_STAGE
#undef PG8_LDA
#undef PG8_LDB
#undef PG8_MMA
#undef PG8_WAIT_V
#undef PG8_WAIT_L
#undef PG8_BAR
#undef PG8_SCHED
}
}

constexpr int NWAVES = 8, NTHREADS = 512;
constexpr int D = 2048, MP = 8192, MS = 1024, M = MP + MS, LP = 2048, LS = 8, BP = 4, BS = 128;
constexpr int INW = 6144, DFF = 8192, NH = 8, DK = 128, SGW = 1024, NMOD = 6 * D, NMODROWS = BP + BS;
constexpr int NCH = LP / 128;
constexpr int PAST = 16384;
constexpr float EPS = 1e-6f;
constexpr int ZQ = 0, ZK = 1024, ZV = 2048, ZG = 3072, ZU = 4096, ZVS = 5120;
constexpr size_t OUT_Y = 0, OUT_SP = (size_t)M * D, OUT_SS = OUT_SP + (size_t)BP * NH * DK * DK, OUT_VN = OUT_SS + (size_t)BS * NH * DK * DK;
constexpr size_t MiB = 1u << 20;
constexpr size_t WS_CTL = 0, CTL_ZERO_BYTES = 16384;
constexpr size_t WS_WIN = 1 * MiB, WS_WO = 25 * MiB, WS_W1 = 33 * MiB, WS_W2 = 65 * MiB, WS_MOD = 97 * MiB, WS_ROPE = 104 * MiB;
constexpr size_t WS_H = 106 * MiB, WS_CAT = 142 * MiB, WS_MB = 178 * MiB, WS_VN = 214 * MiB, WS_Z = 230 * MiB, WS_KV = 338 * MiB, WS_SPV = 370 * MiB;
constexpr size_t WS_F1 = 230 * MiB, WS_P3 = 386 * MiB, WS_END = 422 * MiB;
static_assert(WS_F1 + (size_t)M * DFF * 2 <= WS_P3, "f1 overlay");
static_assert(WS_Z + (size_t)M * INW * 2 <= WS_KV, "z");
constexpr int LDS_BYTES = 147456, MISC_OFF = 147456 - 64;
constexpr int RS = 272, TILE_B = 128 * RS;
static_assert(4 * TILE_B <= LDS_BYTES, "tiles");

struct Args { const float* in[19]; float* out; unsigned char* ws; int ph_lo, ph_hi; };

#define XB_TMO      128
#define XB_XCNT(j)  (256  + 64 * (j))
#define XB_XSUB(j)  (1280 + 64 * (j))
#define XB_XGEN(j)  (2304 + 64 * (j))
#define XB_TOP      3328
#define XB_TOPGEN   3392
#define XCD_BAR_WORDS 3456
#define XB_SPIN_CAP (1u << 18)

__device__ __forceinline__ unsigned xb_ld(unsigned* p)              { return __hip_atomic_load(p, __ATOMIC_RELAXED, __HIP_MEMORY_SCOPE_AGENT); }
__device__ __forceinline__ unsigned xb_add(unsigned* p, unsigned v) { return __hip_atomic_fetch_add(p, v, __ATOMIC_RELAXED, __HIP_MEMORY_SCOPE_AGENT); }
__device__ __forceinline__ unsigned xb_xcc_id() { return (unsigned)__builtin_amdgcn_s_getreg((3 << 11) | 20) & 0xFu; }
#define XB_SPIN(cond, bar) do { unsigned _sp = 0; while (cond) { __builtin_amdgcn_s_sleep(1); \
    if ((++_sp & 255u) == 0u) { if (xb_ld(&(bar)[XB_TMO])) break; if (_sp > XB_SPIN_CAP) { atomicAdd(&(bar)[XB_TMO], 1u); break; } } } } while (0)

struct XcdBarrier {
    unsigned* bar; unsigned x;
    volatile LAS unsigned* st;
};

__device__ __forceinline__ XcdBarrier xcd_barrier_post(unsigned* bar, volatile LAS unsigned* st) {
    XcdBarrier b; b.bar = bar; b.x = xb_xcc_id(); b.st = st;
    if (threadIdx.x == 0) (void)xb_add(&bar[XB_XCNT(b.x)], 1u);
    return b;
}
__device__ __forceinline__ void xcd_barrier_complete(unsigned* bar, unsigned x, unsigned& nloc, unsigned& nx) {
    const unsigned G = gridDim.x * gridDim.y * gridDim.z;
    unsigned sum, cnt, mine, sp = 0u;
    for (;;) {
        sum = 0u; cnt = 0u; mine = 0u;
#pragma unroll
        for (unsigned j = 0; j < 16; ++j) { const unsigned c = xb_ld(&bar[XB_XCNT(j)]); sum += c; cnt += (c > 0u) ? 1u : 0u; mine = (j == x) ? c : mine; }
        if (sum == G) break;
        __builtin_amdgcn_s_sleep(1);
        if ((++sp & 255u) == 0u) { if (xb_ld(&bar[XB_TMO])) break; if (sp > XB_SPIN_CAP) { atomicAdd(&bar[XB_TMO], 1u); break; } }
    }
    nloc = mine > 0u ? mine : 1u; nx = cnt > 0u ? cnt : 1u;
}

__device__ __forceinline__ void xcd_barrier(const XcdBarrier& b) {
    asm volatile("s_waitcnt vmcnt(0)" ::: "memory");
    __syncthreads();
    if (threadIdx.x == 0) {
        unsigned* bar = b.bar;
        __builtin_amdgcn_s_waitcnt(0);
        unsigned nloc = b.st[0], nx = b.st[1];
        if (nloc == 0u) { xcd_barrier_complete(bar, b.x, nloc, nx); b.st[0] = nloc; b.st[1] = nx; }
        const unsigned old = xb_add(&bar[XB_XSUB(b.x)], 1u);
        const unsigned gen = old / nloc;
        if (old + 1u == (gen + 1u) * nloc) {
            __builtin_amdgcn_fence(__ATOMIC_RELEASE, "agent");
            asm volatile("s_waitcnt vmcnt(0)" ::: "memory");
            const unsigned og = xb_add(&bar[XB_TOP], 1u);
            const unsigned tg = og / nx;
            if (og + 1u == (tg + 1u) * nx) xb_add(&bar[XB_TOPGEN], 1u);
            else XB_SPIN(xb_ld(&bar[XB_TOPGEN]) == tg, bar);
            __builtin_amdgcn_fence(__ATOMIC_ACQUIRE, "agent");
            xb_add(&bar[XB_XGEN(b.x)], 1u);
            asm volatile("s_waitcnt vmcnt(0)" ::: "memory");
        } else {
            XB_SPIN(xb_ld(&bar[XB_XGEN(b.x)]) == gen, bar);
            __builtin_amdgcn_fence(__ATOMIC_ACQUIRE, "agent");
            asm volatile("s_waitcnt vmcnt(0)" ::: "memory");
        }
    }
    __syncthreads();
}


__device__ __forceinline__ unsigned pk2(float lo, float hi) { return pg8::cvt_pk_bf16(lo, hi); }
__device__ __forceinline__ float bf_lo(unsigned u) { return __uint_as_float(u << 16); }
__device__ __forceinline__ float bf_hi(unsigned u) { return __uint_as_float(u & 0xffff0000u); }
__device__ __forceinline__ float bf1(bf16 b) { return __uint_as_float(((unsigned)b) << 16); }
__device__ __forceinline__ bf16 f2bf(float f) { return (bf16)(pk2(f, 0.f) & 0xffffu); }
__device__ __forceinline__ float wave_sum(float v) {
#pragma unroll
    for (int o = 1; o < 64; o <<= 1) v += __shfl_xor(v, o);
    return v;
}
__device__ __forceinline__ float sum16(float v) { v += __shfl_xor(v, 1); v += __shfl_xor(v, 2); v += __shfl_xor(v, 4); v += __shfl_xor(v, 8); return v; }
__device__ __forceinline__ float log2gamma(int h) { return log2f(1.0f - exp2f(-5.0f - (float)h)); }
__device__ __forceinline__ int modrow(int m) { return m < MP ? (m >> 11) : BP + ((m - MP) >> 3); }

__device__ __forceinline__ bf16x8 ld_row(LAS unsigned char* tile, int r0, int k0, int lane) {
    return *(const LAS bf16x8*)(tile + (r0 + (lane & 15)) * RS + (k0 + 8 * (lane >> 4)) * 2);
}
__device__ __forceinline__ unsigned tr_base(LAS unsigned char* tile, int c0, int lane) {
    const int g = lane >> 4, i = lane & 15, q = i >> 2, p = i & 3;
    return (unsigned)(uintptr_t)(tile + (8 * g + q) * RS + (c0 + 4 * p) * 2);
}
__device__ __forceinline__ bf16x8 ld_tr(unsigned base, const int OFF) {
    s16x4 lo, hi;
    asm volatile("ds_read_b64_tr_b16 %0, %2 offset:%3\n\tds_read_b64_tr_b16 %1, %2 offset:%4\n\ts_waitcnt lgkmcnt(0)" : "=&v"(lo), "=&v"(hi) : "v"(base), "n"(OFF), "n"(OFF + 4 * RS) : "memory");
    return __builtin_shufflevector(lo, hi, 0, 1, 2, 3, 4, 5, 6, 7);
}
static_assert(4 * RS == 1088, "tr offset");
#define MFMA16(a, b, c) __builtin_amdgcn_mfma_f32_16x16x32_bf16((a), (b), (c), 0, 0, 0)

__device__ __forceinline__ void stage_copy(LAS unsigned char* tile, const bf16* src, size_t stride, int tid) {
#pragma unroll
    for (int it = 0; it < 4; ++it) { const int idx = tid + NTHREADS * it, r = idx >> 4, ch = idx & 15;
        *(LAS v4u*)(tile + r * RS + 16 * ch) = *(const v4u*)(src + (size_t)r * stride + 8 * ch); }
}
template <bool SDEC>
__device__ __forceinline__ void stage_rot(LAS unsigned char* tile, const bf16* src  , const float* rope  , float scale, float l2g, int tid) {
#pragma unroll
    for (int it = 0; it < 2; ++it) {
        const int idx = tid + NTHREADS * it, r = idx >> 3, ch = idx & 7;
        const bf16* s = src + (size_t)r * INW + 8 * ch;
        const v4u x1 = *(const v4u*)s, x2 = *(const v4u*)(s + 64);
        const f32x4* cs = (const f32x4*)(rope + ((size_t)r * 64 + 8 * ch) * 2);
        const float rs = SDEC ? scale * exp2f((float)(127 - r) * l2g) : scale;
        v4u o1, o2;
#pragma unroll
        for (int e = 0; e < 4; ++e) {
            const f32x4 c = cs[e];
            const float a0 = bf_lo(x1[e]), a1 = bf_hi(x1[e]), b0 = bf_lo(x2[e]), b1 = bf_hi(x2[e]);
            o1[e] = pk2((a0 * c[0] - b0 * c[1]) * rs, (a1 * c[2] - b1 * c[3]) * rs);
            o2[e] = pk2((a0 * c[1] + b0 * c[0]) * rs, (a1 * c[3] + b1 * c[2]) * rs);
        }
        *(LAS v4u*)(tile + r * RS + 16 * ch) = o1;
        *(LAS v4u*)(tile + r * RS + 128 + 16 * ch) = o2;
    }
}

__device__ __forceinline__ void p0_transpose_item(const float* W, int K, int N, bf16* WT, LAS float* scr, int item, int lane) {
    const int nblk = N / 32, kb = item / nblk, nb = item % nblk, k0 = 64 * kb, n0 = 32 * nb;
    float tv[32];
#pragma unroll
    for (int i = 0; i < 32; ++i) tv[i] = W[(size_t)(k0 + 2 * i + (lane >> 5)) * N + n0 + (lane & 31)];
#pragma unroll
    for (int i = 0; i < 32; ++i) scr[(2 * i + (lane >> 5)) * 33 + (lane & 31)] = tv[i];
    asm volatile("s_waitcnt lgkmcnt(0)" ::: "memory");
    const int c = lane & 7;
#pragma unroll
    for (int j = 0; j < 4; ++j) { const int n = (lane >> 3) + 8 * j; const LAS float* s = scr + (8 * c) * 33 + n;
        v4u o; o.x = pk2(s[0 * 33], s[1 * 33]); o.y = pk2(s[2 * 33], s[3 * 33]); o.z = pk2(s[4 * 33], s[5 * 33]); o.w = pk2(s[6 * 33], s[7 * 33]);
        *(v4u*)(WT + (size_t)(n0 + n) * K + k0 + 8 * c) = o; }
    asm volatile("s_waitcnt lgkmcnt(0)" ::: "memory");
}

__device__ __forceinline__ void p0_mod_slab(const Args& a, LAS unsigned char* lds, int slab, int tid, int wave, int lane) {
    const float* cp = a.in[3]; const float* cs = a.in[4]; const float* wada = a.in[5]; const float* bada = a.in[6];
    float* mod = (float*)(a.ws + WS_MOD);
    LAS float* red = (LAS float*)(lds + 67584);
    const int n0 = slab * 64, j = lane & 15, kq = lane >> 4;
    f32x4 acc[9][4];
#pragma unroll
    for (int mt = 0; mt < 9; ++mt)
#pragma unroll
        for (int jj = 0; jj < 4; ++jj) acc[mt][jj] = (f32x4){0.f, 0.f, 0.f, 0.f};
    for (int ks = 0; ks < 8; ++ks) {
        const int k0 = 256 * wave + 32 * ks + 8 * kq;
        f32x4 wv[8];
#pragma unroll
        for (int i = 0; i < 8; ++i) wv[i] = *(const f32x4*)(wada + (size_t)(k0 + i) * NMOD + n0 + 4 * j);
        bf16x8 bop[4];
#pragma unroll
        for (int jj = 0; jj < 4; ++jj) { v4u w; w.x = pk2(wv[0][jj], wv[1][jj]); w.y = pk2(wv[2][jj], wv[3][jj]); w.z = pk2(wv[4][jj], wv[5][jj]); w.w = pk2(wv[6][jj], wv[7][jj]); bop[jj] = __builtin_bit_cast(bf16x8, w); }
#pragma unroll
        for (int mt = 0; mt < 9; ++mt) {
            int r = 16 * mt + j; r = r < NMODROWS ? r : NMODROWS - 1;
            const float* crow = r < BP ? cp + (size_t)r * D : cs + (size_t)(r - BP) * D;
            const f32x4 c0 = *(const f32x4*)(crow + k0), c1 = *(const f32x4*)(crow + k0 + 4);
            v4u w; w.x = pk2(pg8::silu_(c0[0]), pg8::silu_(c0[1])); w.y = pk2(pg8::silu_(c0[2]), pg8::silu_(c0[3]));
            w.z = pk2(pg8::silu_(c1[0]), pg8::silu_(c1[1])); w.w = pk2(pg8::silu_(c1[2]), pg8::silu_(c1[3]));
            const bf16x8 aop = __builtin_bit_cast(bf16x8, w);
#pragma unroll
            for (int jj = 0; jj < 4; ++jj) acc[mt][jj] = MFMA16(aop, bop[jj], acc[mt][jj]);
        }
    }
    for (int w = 0; w < 8; ++w) {
        if (wave == w) {
#pragma unroll
            for (int mt = 0; mt < 9; ++mt)
#pragma unroll
                for (int r = 0; r < 4; ++r) {
                    LAS f32x4* p = (LAS f32x4*)(red + (16 * mt + 4 * kq + r) * 64 + 4 * j);
                    f32x4 v = (f32x4){acc[mt][0][r], acc[mt][1][r], acc[mt][2][r], acc[mt][3][r]};
                    if (w) v += *p;
                    *p = v;
                }
        }
        __syncthreads();
    }
    for (int idx = tid; idx < NMODROWS * 64; idx += NTHREADS) { const int row = idx >> 6, col = idx & 63; mod[(size_t)row * NMOD + n0 + col] = red[idx] + bada[n0 + col]; }
    __syncthreads();
}

__device__ __forceinline__ void p0_prologue(const Args& a, LAS unsigned char* lds, int G, int bid, int tid, int wave, int lane) {
    for (int slab = bid; slab < NMOD / 64; slab += G) p0_mod_slab(a, lds, slab, tid, wave, lane);
    {
        float* rope = (float*)(a.ws + WS_ROPE);
        for (int idx = bid * NTHREADS + tid; idx < (LP + LS) * 64; idx += G * NTHREADS) {
            const int p = idx >> 6, jf = idx & 63; const int pos = p < LP ? p : PAST + (p - LP);
            const double inv = exp2(-(double)jf * (13.287712379549449 / 64.0));
            const double ang = (double)pos * inv;
            const double n = rint(ang * 0.15915494309189535);
            double r = fma(-n, 6.283185307179586, ang); r = fma(-n, 2.4492935982947064e-16, r);
            rope[2 * idx] = (float)cos(r); rope[2 * idx + 1] = (float)sin(r);
        }
    }
    LAS float* scr = (LAS float*)(lds + wave * 8448);
    const int gw = bid * NWAVES + wave, NGW = G * NWAVES;
    constexpr int I_IN = (D / 64) * (INW / 32);
    for (int it = gw; it < I_IN; it += NGW) p0_transpose_item(a.in[11], D, INW, (bf16*)(a.ws + WS_WIN), scr, it, lane);
}
__device__ __forceinline__ void late_transposes(const Args& a, LAS unsigned char* lds, int nb, int ib, int wave, int lane) {
    LAS float* scr = (LAS float*)(lds + wave * 8448);
    const int gw = ib * NWAVES + wave, NGW = nb * NWAVES;
    constexpr int I_O = (D / 64) * (D / 32), I_1 = (D / 64) * (DFF / 32), I_2 = (DFF / 64) * (D / 32);
    for (int it = gw; it < I_O + I_1 + I_2; it += NGW) {
        int r = it;
        if (r < I_O) { p0_transpose_item(a.in[16], D, D, (bf16*)(a.ws + WS_WO), scr, r, lane); continue; } r -= I_O;
        if (r < I_1) { p0_transpose_item(a.in[17], D, DFF, (bf16*)(a.ws + WS_W1), scr, r, lane); continue; } r -= I_1;
        p0_transpose_item(a.in[18], DFF, D, (bf16*)(a.ws + WS_W2), scr, r, lane);
    }
}

__device__ __forceinline__ const float* xrow(const Args& a, int m) { return m < MP ? a.in[0] + (size_t)m * D : a.in[1] + (size_t)(m - MP) * D; }

__device__ __forceinline__ void p1_rows(const Args& a, int G, int bid, int wave, int lane) {
    const float* mod = (const float*)(a.ws + WS_MOD); const float* g = a.in[7]; bf16* H = (bf16*)(a.ws + WS_H);
    for (int m = bid * NWAVES + wave; m < M; m += G * NWAVES) {
        const f32x4* xr = (const f32x4*)xrow(a, m) + lane; const float* md = mod + (size_t)modrow(m) * NMOD;
        f32x4 v[8]; float ss = 0.f;
#pragma unroll
        for (int j = 0; j < 8; ++j) { v[j] = xr[64 * j]; ss += (v[j][0] * v[j][0] + v[j][1] * v[j][1]) + (v[j][2] * v[j][2] + v[j][3] * v[j][3]); }
        const float rstd = 1.0f / sqrtf(wave_sum(ss) * (1.0f / D) + EPS);
#pragma unroll
        for (int j = 0; j < 8; ++j) { const int col = 4 * (lane + 64 * j);
            const f32x4 gg = *(const f32x4*)(g + col), sh = *(const f32x4*)(md + col), sc = *(const f32x4*)(md + D + col);
            const f32x4 o = v[j] * rstd * gg * (sc + 1.0f) + sh;
            v2u w; w.x = pk2(o[0], o[1]); w.y = pk2(o[2], o[3]); *(v2u*)(H + (size_t)m * D + col) = w; }
    }
}
__device__ __forceinline__ void p7_rows(const Args& a, int G, int bid, int wave, int lane) {
    const float* mod = (const float*)(a.ws + WS_MOD); const float* gpost = a.in[8]; const float* gpre = a.in[9];
    bf16* H = (bf16*)(a.ws + WS_H); const bf16* MB = (const bf16*)(a.ws + WS_MB);
    for (int m = bid * NWAVES + wave; m < M; m += G * NWAVES) {
        const f32x4* xr = (const f32x4*)xrow(a, m) + lane; const float* md = mod + (size_t)modrow(m) * NMOD;
        const v2u* mr = (const v2u*)(MB + (size_t)m * D) + lane; const v2u* mr1 = (const v2u*)((const bf16*)(a.ws + WS_Z) + (size_t)m * D) + lane;
        f32x4 v[8]; float ss = 0.f;
#pragma unroll
        for (int j = 0; j < 8; ++j) { const v2u w = mr[64 * j], w1 = mr1[64 * j]; v[j] = (f32x4){bf_lo(w.x) + bf_lo(w1.x), bf_hi(w.x) + bf_hi(w1.x), bf_lo(w.y) + bf_lo(w1.y), bf_hi(w.y) + bf_hi(w1.y)}; ss += (v[j][0] * v[j][0] + v[j][1] * v[j][1]) + (v[j][2] * v[j][2] + v[j][3] * v[j][3]); }
        const float rstd = 1.0f / sqrtf(wave_sum(ss) * (1.0f / D) + EPS);
        float s2 = 0.f;
#pragma unroll
        for (int j = 0; j < 8; ++j) { const int col = 4 * (lane + 64 * j);
            const f32x4 gg = *(const f32x4*)(gpost + col), gt = *(const f32x4*)(md + 2 * D + col);
            const f32x4 x1 = xr[64 * j] + gt * (v[j] * rstd * gg);
            v[j] = x1; s2 += (x1[0] * x1[0] + x1[1] * x1[1]) + (x1[2] * x1[2] + x1[3] * x1[3]);
            *(f32x4*)(a.out + OUT_Y + (size_t)m * D + col) = x1; }
        const float rstd2 = 1.0f / sqrtf(wave_sum(s2) * (1.0f / D) + EPS);
#pragma unroll
        for (int j = 0; j < 8; ++j) { const int col = 4 * (lane + 64 * j);
            const f32x4 gg = *(const f32x4*)(gpre + col), sh = *(const f32x4*)(md + 3 * D + col), sc = *(const f32x4*)(md + 4 * D + col);
            const f32x4 o = v[j] * rstd2 * gg * (sc + 1.0f) + sh;
            v2u w; w.x = pk2(o[0], o[1]); w.y = pk2(o[2], o[3]); *(v2u*)(H + (size_t)m * D + col) = w; }
    }
}
__device__ __forceinline__ void p10_rows(const Args& a, int G, int bid, int wave, int lane) {
    const float* mod = (const float*)(a.ws + WS_MOD); const float* gpost = a.in[10]; const bf16* MB = (const bf16*)(a.ws + WS_MB);
    for (int m = bid * NWAVES + wave; m < M; m += G * NWAVES) {
        f32x4* yr = (f32x4*)(a.out + OUT_Y + (size_t)m * D) + lane; const float* md = mod + (size_t)modrow(m) * NMOD;
        const v2u* mr = (const v2u*)(MB + (size_t)m * D) + lane; const v2u* mr1 = (const v2u*)((const bf16*)(a.ws + WS_CAT) + (size_t)m * D) + lane;
        const v2u* mr2 = (const v2u*)((const bf16*)(a.ws + WS_H) + (size_t)m * D) + lane; const v2u* mr3 = (const v2u*)((const bf16*)(a.ws + WS_P3) + (size_t)m * D) + lane;
        f32x4 v[8]; float ss = 0.f;
#pragma unroll
        for (int j = 0; j < 8; ++j) { const v2u w = mr[64 * j], w1 = mr1[64 * j], w2 = mr2[64 * j], w3 = mr3[64 * j];
            v[j] = (f32x4){(bf_lo(w.x) + bf_lo(w1.x)) + (bf_lo(w2.x) + bf_lo(w3.x)), (bf_hi(w.x) + bf_hi(w1.x)) + (bf_hi(w2.x) + bf_hi(w3.x)), (bf_lo(w.y) + bf_lo(w1.y)) + (bf_lo(w2.y) + bf_lo(w3.y)), (bf_hi(w.y) + bf_hi(w1.y)) + (bf_hi(w2.y) + bf_hi(w3.y))};
            ss += (v[j][0] * v[j][0] + v[j][1] * v[j][1]) + (v[j][2] * v[j][2] + v[j][3] * v[j][3]); }
        const float rstd = 1.0f / sqrtf(wave_sum(ss) * (1.0f / D) + EPS);
#pragma unroll
        for (int j = 0; j < 8; ++j) { const int col = 4 * (lane + 64 * j);
            const f32x4 gg = *(const f32x4*)(gpost + col), gt = *(const f32x4*)(md + 5 * D + col);
            yr[64 * j] = yr[64 * j] + gt * (v[j] * rstd * gg); }
    }
}

__device__ __forceinline__ void vn_row(const bf16* zrow, const float* lng, const float* lnb, int lane, float (&o)[2][8]) {
    float s = 0.f;
#pragma unroll
    for (int jj = 0; jj < 2; ++jj) { const v4u w = *(const v4u*)(zrow + ZVS + 8 * (lane + 64 * jj));
#pragma unroll
        for (int e = 0; e < 4; ++e) { o[jj][2 * e] = bf_lo(w[e]); o[jj][2 * e + 1] = bf_hi(w[e]); s += o[jj][2 * e] + o[jj][2 * e + 1]; } }
    const float mean = wave_sum(s) * (1.0f / SGW); float q = 0.f;
#pragma unroll
    for (int jj = 0; jj < 2; ++jj)
#pragma unroll
        for (int e = 0; e < 8; ++e) { o[jj][e] -= mean; q += o[jj][e] * o[jj][e]; }
    const float rstd = 1.0f / sqrtf(wave_sum(q) * (1.0f / SGW) + EPS);
#pragma unroll
    for (int jj = 0; jj < 2; ++jj) { const int col = 8 * (lane + 64 * jj);
#pragma unroll
        for (int e = 0; e < 8; ++e) o[jj][e] = o[jj][e] * rstd * lng[col + e] + lnb[col + e]; }
}

__device__ __forceinline__ void p3_phase(const Args& a, LAS unsigned char* lds, int G, int bid, int tid, int wave, int lane) {
    const bf16* Z = (const bf16*)(a.ws + WS_Z); const float* rope = (const float*)(a.ws + WS_ROPE);
    float* KV = (float*)(a.ws + WS_KV); bf16* CAT = (bf16*)(a.ws + WS_CAT); bf16* VN = (bf16*)(a.ws + WS_VN);
    const float* lng = a.in[14]; const float* lnb = a.in[15];
    const int j = lane & 15, rq = lane >> 4;
    LAS unsigned char* t0 = lds; LAS unsigned char* t1 = lds + TILE_B;
    constexpr int NT_KV = BP * NH * NCH, NT_SB = BS, NT_SR = BS * NH / 4;
    for (int T = bid; T < NT_KV + NT_SB + NT_SR; T += G) {
        if (T < NT_KV) {
            const int c = T % NCH, h = (T / NCH) % NH, b = T / (NCH * NH);
            const size_t row0 = (size_t)b * LP + c * 128; const float l2g = log2gamma(h);
            stage_rot<true>(t0, Z + row0 * INW + ZK + h * DK, rope + (size_t)(c * 128) * 128, 0.08838834764831845f, l2g, tid);
            stage_copy(t1, Z + row0 * INW + ZV + h * DK, INW, tid);
            __syncthreads();
            f32x4 acc[8];
            const unsigned trA = tr_base(t0, 16 * wave, lane), trB_t1 = tr_base(t1, 0, lane);
#pragma unroll
            for (int nt = 0; nt < 8; ++nt) acc[nt] = (f32x4){0.f, 0.f, 0.f, 0.f};
#pragma unroll
            for (int ks = 0; ks < 4; ++ks) { const bf16x8 aop = ld_tr(trA, ks * (32 * RS));
#pragma unroll
                for (int nt = 0; nt < 8; ++nt) { const bf16x8 bop = ld_tr(trB_t1, ks * (32 * RS) + nt * 32); acc[nt] = MFMA16(aop, bop, acc[nt]); } }
            float* kv = KV + (size_t)T * (DK * DK);
#pragma unroll
            for (int nt = 0; nt < 8; ++nt)
#pragma unroll
                for (int r = 0; r < 4; ++r) kv[(16 * wave + 4 * rq + r) * DK + 16 * nt + j] = acc[nt][r];
            __syncthreads();
        } else if (T < NT_KV + NT_SB) {
            const int b = T - NT_KV; const int row = MP + b * LS + wave; const bf16* zrow = Z + (size_t)row * INW;
            LAS float* vl = (LAS float*)lds;
            float o[2][8]; vn_row(zrow, lng, lnb, lane, o);
#pragma unroll
            for (int jj = 0; jj < 2; ++jj) { const int col = 8 * (lane + 64 * jj);
                float* dst = a.out + OUT_VN + (size_t)(b * LS + wave) * SGW + col;
                *(f32x4*)dst = (f32x4){o[jj][0], o[jj][1], o[jj][2], o[jj][3]}; *(f32x4*)(dst + 4) = (f32x4){o[jj][4], o[jj][5], o[jj][6], o[jj][7]};
                *(LAS f32x4*)(vl + wave * SGW + col) = (f32x4){o[jj][0], o[jj][1], o[jj][2], o[jj][3]}; *(LAS f32x4*)(vl + wave * SGW + col + 4) = (f32x4){o[jj][4], o[jj][5], o[jj][6], o[jj][7]}; }
            __syncthreads();
            const float* ws_ = a.in[12]; const float* bs_ = a.in[13];
#pragma unroll
            for (int jj = 0; jj < 2; ++jj) { const int col = 8 * (lane + 64 * jj), g = col >> 7;
                float s[8]; const float bias = bs_[g * 128 + wave];
#pragma unroll
                for (int e = 0; e < 8; ++e) s[e] = bias;
                for (int sp = 0; sp <= wave; ++sp) { const float w = ws_[(size_t)g * 16384 + wave * 128 + sp];
                    const f32x4 v0 = *(const LAS f32x4*)(vl + sp * SGW + col), v1 = *(const LAS f32x4*)(vl + sp * SGW + col + 4);
                    s[0] += w * v0[0]; s[1] += w * v0[1]; s[2] += w * v0[2]; s[3] += w * v0[3]; s[4] += w * v1[0]; s[5] += w * v1[1]; s[6] += w * v1[2]; s[7] += w * v1[3]; }
                const v4u u = *(const v4u*)(zrow + ZU + col); v4u w;
#pragma unroll
                for (int e = 0; e < 4; ++e) w[e] = pk2(s[2 * e] * bf_lo(u[e]), s[2 * e + 1] * bf_hi(u[e]));
                *(v4u*)(CAT + (size_t)row * D + SGW + col) = w; }
            __syncthreads();
        } else {
            const int t4 = T - NT_KV - NT_SB; const int pr = wave >> 1, eh = wave & 1; const int bh = 4 * t4 + pr, b = bh >> 3, h = bh & 7;
            const int e = 64 * eh + lane; const size_t row0 = (size_t)MP + (size_t)b * LS; const float l2g = log2gamma(h);
            LAS float* qT = (LAS float*)(lds + pr * 8192);
            LAS float* kT = (LAS float*)(lds + pr * 8192 + 4096);
            LAS float* scl = (LAS float*)(lds + 32768 + wave * 256);
            LAS float* part = (LAS float*)(lds + 36864);
            {
                const int colb = (eh ? ZK : ZQ) + h * DK; const float sc = eh ? 0.08838834764831845f : 1.0f; LAS float* dst = eh ? kT : qT;
#pragma unroll
                for (int n = 0; n < 8; ++n) { const bf16* s = Z + (row0 + n) * INW + colb;
                    const float x1 = bf1(s[lane]), x2 = bf1(s[lane + 64]); const float c = rope[((size_t)(LP + n) * 64 + lane) * 2], sn = rope[((size_t)(LP + n) * 64 + lane) * 2 + 1];
                    dst[lane * 8 + n] = (x1 * c - x2 * sn) * sc; dst[(lane + 64) * 8 + n] = (x1 * sn + x2 * c) * sc; }
            }
            float v[8], vs[8];
#pragma unroll
            for (int m = 0; m < 8; ++m) { v[m] = bf1(Z[(row0 + m) * INW + ZV + h * DK + e]); vs[m] = v[m] * exp2f((float)(7 - m) * l2g); }
            __syncthreads();
            {
                const int n = lane >> 3, m = lane & 7; float s = 0.f;
                for (int d = 0; d < DK; ++d) s += qT[d * 8 + n] * kT[d * 8 + m];
                scl[lane] = n >= m ? s * exp2f((float)(n - m) * l2g) : 0.f;
            }
            const float cdec = exp2f(8.0f * l2g);
            const float* S0 = a.in[2] + (size_t)bh * (DK * DK) + e; float* S1 = a.out + OUT_SS + (size_t)bh * (DK * DK) + e;
            float oa[8];
#pragma unroll
            for (int n = 0; n < 8; ++n) oa[n] = 0.f;
            for (int d0 = 0; d0 < DK; d0 += 8) {
                float s0[8];
#pragma unroll
                for (int i = 0; i < 8; ++i) s0[i] = S0[(size_t)(d0 + i) * DK];
#pragma unroll
                for (int i = 0; i < 8; ++i) { const int d = d0 + i;
                    const f32x4 q0 = *(const LAS f32x4*)(qT + d * 8), q1 = *(const LAS f32x4*)(qT + d * 8 + 4), k0 = *(const LAS f32x4*)(kT + d * 8), k1 = *(const LAS f32x4*)(kT + d * 8 + 4);
                    oa[0] += q0[0] * s0[i]; oa[1] += q0[1] * s0[i]; oa[2] += q0[2] * s0[i]; oa[3] += q0[3] * s0[i];
                    oa[4] += q1[0] * s0[i]; oa[5] += q1[1] * s0[i]; oa[6] += q1[2] * s0[i]; oa[7] += q1[3] * s0[i];
                    float sn = s0[i] * cdec;
                    sn += k0[0] * vs[0] + k0[1] * vs[1] + k0[2] * vs[2] + k0[3] * vs[3] + k1[0] * vs[4] + k1[1] * vs[5] + k1[2] * vs[6] + k1[3] * vs[7];
                    S1[(size_t)d * DK] = sn; }
            }
            float su[8], sq[8];
#pragma unroll
            for (int n = 0; n < 8; ++n) { float o = oa[n] * exp2f((float)(n + 1) * l2g);
#pragma unroll
                for (int m = 0; m < 8; ++m) if (m <= n) o += scl[n * 8 + m] * v[m];
                oa[n] = o; su[n] = wave_sum(o); sq[n] = wave_sum(o * o); }
            if (lane == 0) {
#pragma unroll
                for (int n = 0; n < 8; ++n) { part[wave * 16 + n] = su[n]; part[wave * 16 + 8 + n] = sq[n]; } }
            __syncthreads();
#pragma unroll
            for (int n = 0; n < 8; ++n) { const float s1 = su[n] + part[(wave ^ 1) * 16 + n], s2 = sq[n] + part[(wave ^ 1) * 16 + 8 + n];
                const float mean = s1 * (1.0f / DK); float var = s2 * (1.0f / DK) - mean * mean; var = var > 0.f ? var : 0.f;
                const float on = (oa[n] - mean) * (1.0f / sqrtf(var + EPS));
                const float g = bf1(Z[(row0 + n) * INW + ZG + h * DK + e]);
                CAT[(row0 + n) * D + h * DK + e] = f2bf(on * g); }
            __syncthreads();
        }
    }
    for (int m = bid * NWAVES + wave; m < MP; m += G * NWAVES) {
        float o[2][8]; vn_row(Z + (size_t)m * INW, lng, lnb, lane, o);
#pragma unroll
        for (int jj = 0; jj < 2; ++jj) { v4u w;
#pragma unroll
            for (int e = 0; e < 4; ++e) w[e] = pk2(o[jj][2 * e], o[jj][2 * e + 1]);
            *(v4u*)(VN + (size_t)m * SGW + 8 * (lane + 64 * jj)) = w; }
    }
}

__device__ __forceinline__ void p4_scan(const Args& a, int G, int bid, int tid) {
    const float* KV = (const float*)(a.ws + WS_KV); bf16* SPV = (bf16*)(a.ws + WS_SPV);
    for (int idx = bid * NTHREADS + tid; idx < BP * NH * DK * DK; idx += G * NTHREADS) {
        const int bh = idx >> 14, de = idx & 16383, h = bh & 7; const float cdec = exp2f(128.0f * log2gamma(h));
        float kv[NCH];
#pragma unroll
        for (int c = 0; c < NCH; ++c) kv[c] = KV[((size_t)bh * NCH + c) * (DK * DK) + de];
        float S = 0.f;
#pragma unroll
        for (int c = 0; c < NCH; ++c) { SPV[((size_t)bh * NCH + c) * (DK * DK) + de] = f2bf(S); S = S * cdec + kv[c]; }
        a.out[OUT_SP + idx] = S;
    }
}

__device__ __forceinline__ void p5_phase(const Args& a, LAS unsigned char* lds, int G, int bid, int tid, int wave, int lane) {
    const bf16* Z = (const bf16*)(a.ws + WS_Z); const float* rope = (const float*)(a.ws + WS_ROPE);
    const bf16* SPV = (const bf16*)(a.ws + WS_SPV); bf16* CAT = (bf16*)(a.ws + WS_CAT); const bf16* VN = (const bf16*)(a.ws + WS_VN);
    const int j = lane & 15, rq = lane >> 4;
    LAS unsigned char* t0 = lds; LAS unsigned char* t1 = lds + TILE_B; LAS unsigned char* t2 = lds + 2 * TILE_B; LAS unsigned char* t3 = lds + 3 * TILE_B;
    constexpr int NT_R = BP * NH * NCH, NT_S = BP * NCH * 8;
    const int kmax = (16 * wave + 15) >> 5;
    for (int T = bid; T < NT_R + NT_S; T += G) {
        if (T < NT_R) {
            const int c = T % NCH, h = (T / NCH) % NH, b = T / (NCH * NH);
            const size_t row0 = (size_t)b * LP + c * 128; const float l2g = log2gamma(h);
            stage_rot<false>(t0, Z + row0 * INW + ZQ + h * DK, rope + (size_t)(c * 128) * 128, 1.0f, l2g, tid);
            stage_rot<false>(t1, Z + row0 * INW + ZK + h * DK, rope + (size_t)(c * 128) * 128, 0.08838834764831845f, l2g, tid);
            stage_copy(t2, Z + row0 * INW + ZV + h * DK, INW, tid);
            stage_copy(t3, SPV + (size_t)T * (DK * DK), DK, tid);
            __syncthreads();
            f32x4 s[8];
#pragma unroll
            for (int nt = 0; nt < 8; ++nt) s[nt] = (f32x4){0.f, 0.f, 0.f, 0.f};
#pragma unroll
            for (int ks = 0; ks < 4; ++ks) { const bf16x8 aop = ld_row(t0, 16 * wave, 32 * ks, lane);
#pragma unroll
                for (int nt = 0; nt < 8; ++nt) if (nt <= wave) { const bf16x8 bop = ld_row(t1, 16 * nt, 32 * ks, lane); s[nt] = MFMA16(aop, bop, s[nt]); } }
            __syncthreads();
#pragma unroll
            for (int nt = 0; nt < 8; ++nt)
#pragma unroll
                for (int r = 0; r < 4; ++r) { const int n = 16 * wave + 4 * rq + r, mc = 16 * nt + j, dl = n - mc;
                    const float p = dl >= 0 ? s[nt][r] * exp2f((float)dl * l2g) : 0.f;
                    *(LAS bf16*)(t1 + n * RS + mc * 2) = f2bf(p); }
            asm volatile("s_waitcnt lgkmcnt(0)" ::: "memory");
            f32x4 o[8], o2[8];
            const unsigned trB_t2 = tr_base(t2, 0, lane), trB_t3 = tr_base(t3, 0, lane);
#pragma unroll
            for (int nt = 0; nt < 8; ++nt) { o[nt] = (f32x4){0.f, 0.f, 0.f, 0.f}; o2[nt] = (f32x4){0.f, 0.f, 0.f, 0.f}; }
#pragma unroll
            for (int ks = 0; ks < 4; ++ks) if (ks <= kmax) { const bf16x8 aop = ld_row(t1, 16 * wave, 32 * ks, lane);
#pragma unroll
                for (int nt = 0; nt < 8; ++nt) { const bf16x8 bop = ld_tr(trB_t2, ks * (32 * RS) + nt * 32); o[nt] = MFMA16(aop, bop, o[nt]); } }
#pragma unroll
            for (int ks = 0; ks < 4; ++ks) { const bf16x8 aop = ld_row(t0, 16 * wave, 32 * ks, lane);
#pragma unroll
                for (int nt = 0; nt < 8; ++nt) { const bf16x8 bop = ld_tr(trB_t3, ks * (32 * RS) + nt * 32); o2[nt] = MFMA16(aop, bop, o2[nt]); } }
#pragma unroll
            for (int r = 0; r < 4; ++r) { const int n = 16 * wave + 4 * rq + r; const float cr = exp2f((float)(n + 1) * l2g); float sm = 0.f;
#pragma unroll
                for (int nt = 0; nt < 8; ++nt) { o[nt][r] += o2[nt][r] * cr; sm += o[nt][r]; }
                const float mean = sum16(sm) * (1.0f / DK); float q = 0.f;
#pragma unroll
                for (int nt = 0; nt < 8; ++nt) { o[nt][r] -= mean; q += o[nt][r] * o[nt][r]; }
                const float rstd = 1.0f / sqrtf(sum16(q) * (1.0f / DK) + EPS);
#pragma unroll
                for (int nt = 0; nt < 8; ++nt) *(LAS bf16*)(t0 + n * RS + (16 * nt + j) * 2) = f2bf(o[nt][r] * rstd); }
            asm volatile("s_waitcnt lgkmcnt(0)" ::: "memory");
#pragma unroll
            for (int it = 0; it < 4; ++it) { const int idx = lane + 64 * it, rr = idx >> 4, ch = idx & 15; const size_t row = row0 + 16 * wave + rr;
                const v4u on = *(const LAS v4u*)(t0 + (16 * wave + rr) * RS + 16 * ch); const v4u g = *(const v4u*)(Z + row * INW + ZG + h * DK + 8 * ch); v4u w;
#pragma unroll
                for (int e = 0; e < 4; ++e) w[e] = pk2(bf_lo(on[e]) * bf_lo(g[e]), bf_hi(on[e]) * bf_hi(g[e]));
                *(v4u*)(CAT + row * D + h * DK + 8 * ch) = w; }
            __syncthreads();
        } else {
            const int T2 = T - NT_R; const int g = T2 & 7, c = (T2 >> 3) % NCH, b = T2 / (8 * NCH);
            const size_t row0 = (size_t)b * LP + c * 128; const float* W = a.in[12] + (size_t)g * 16384; const float* bs_ = a.in[13] + g * 128;
#pragma unroll
            for (int it = 0; it < 8; ++it) { const int idx = tid + NTHREADS * it, t = idx >> 5, s4 = (idx & 31) * 4;
                const f32x4 w = *(const f32x4*)(W + t * 128 + s4); v2u p;
                p.x = pk2(s4 <= t ? w[0] : 0.f, s4 + 1 <= t ? w[1] : 0.f); p.y = pk2(s4 + 2 <= t ? w[2] : 0.f, s4 + 3 <= t ? w[3] : 0.f);
                *(LAS v2u*)(t0 + t * RS + s4 * 2) = p; }
            stage_copy(t1, VN + row0 * SGW + g * 128, SGW, tid);
            __syncthreads();
            f32x4 acc[8];
            const unsigned trB_t1 = tr_base(t1, 0, lane);
#pragma unroll
            for (int nt = 0; nt < 8; ++nt) acc[nt] = (f32x4){0.f, 0.f, 0.f, 0.f};
#pragma unroll
            for (int ks = 0; ks < 4; ++ks) if (ks <= kmax) { const bf16x8 aop = ld_row(t0, 16 * wave, 32 * ks, lane);
#pragma unroll
                for (int nt = 0; nt < 8; ++nt) { const bf16x8 bop = ld_tr(trB_t1, ks * (32 * RS) + nt * 32); acc[nt] = MFMA16(aop, bop, acc[nt]); } }
#pragma unroll
            for (int r = 0; r < 4; ++r) { const int t = 16 * wave + 4 * rq + r; const float bias = bs_[t];
#pragma unroll
                for (int nt = 0; nt < 8; ++nt) *(LAS bf16*)(t0 + t * RS + (16 * nt + j) * 2) = f2bf(acc[nt][r] + bias); }
            asm volatile("s_waitcnt lgkmcnt(0)" ::: "memory");
#pragma unroll
            for (int it = 0; it < 4; ++it) { const int idx = lane + 64 * it, rr = idx >> 4, ch = idx & 15; const size_t row = row0 + 16 * wave + rr;
                const v4u sv = *(const LAS v4u*)(t0 + (16 * wave + rr) * RS + 16 * ch); const v4u u = *(const v4u*)(Z + row * INW + ZU + g * 128 + 8 * ch); v4u w;
#pragma unroll
                for (int e = 0; e < 4; ++e) w[e] = pk2(bf_lo(sv[e]) * bf_lo(u[e]), bf_hi(sv[e]) * bf_hi(u[e]));
                *(v4u*)(CAT + row * D + SGW + g * 128 + 8 * ch) = w; }
            __syncthreads();
        }
    }
}

constexpr int NPHASE = 11;
__global__ void __launch_bounds__(NTHREADS, 2) fwd_megakernel(Args a) {
    extern __shared__ __attribute__((aligned(16))) unsigned char lds_raw[];
    LAS unsigned char* lds = (LAS unsigned char*)lds_raw;
    cg::grid_group grid = cg::this_grid();
    const int tid = threadIdx.x, lane = tid & 63, wave = __builtin_amdgcn_readfirstlane(tid >> 6);
    const int G = gridDim.x, bid = blockIdx.x;
    const int lo = a.ph_lo, hi = a.ph_hi;
#ifndef PHMASK
#define PHMASK 0x7ff
#endif
#define IN(k) (((PHMASK >> (k)) & 1) && lo <= (k) && (k) < hi)
#define SEAM(k) do { if (IN(k) && IN((k) + 1)) xcd_barrier(bar); } while (0)
    if (lo < 0) grid.sync();
    volatile LAS unsigned* misc = (volatile LAS unsigned*)(lds + MISC_OFF);
    if (tid < 16) misc[tid] = 0u;
    __syncthreads();
    XcdBarrier bar = xcd_barrier_post((unsigned*)(a.ws + WS_CTL), misc);
    unsigned char* ws = a.ws;
    if (IN(0)) p0_prologue(a, lds, G, bid, tid, wave, lane);
    SEAM(0);
    if (IN(1)) p1_rows(a, G, bid, wave, lane);
    SEAM(1);
    if (IN(2)) { pg8::Gemm g{(const bf16*)(ws + WS_H), (const bf16*)(ws + WS_WIN), M, INW, D, D, INW / 256}; pg8::StaticOrder S; S.init(M, INW, G, bid);
        pg8::EpiBf16<1> E{(bf16*)(ws + WS_Z), INW, INW / 256, 0, 0, 0}; pg8::gemm_phase<pg8::EpiBf16<1>, pg8::StaticOrder, true, true>(lds, g, S, E);
        const int nun = (M / 256) * (INW / 256), rem = nun % G;
        if (rem == 0) late_transposes(a, lds, G, bid, wave, lane); else if (bid >= rem) late_transposes(a, lds, G - rem, bid - rem, wave, lane); }
    SEAM(2);
    if (IN(3)) p3_phase(a, lds, G, bid, tid, wave, lane);
    SEAM(3);
    if (IN(4)) p4_scan(a, G, bid, tid);
    SEAM(4);
    if (IN(5)) p5_phase(a, lds, G, bid, tid, wave, lane);
    SEAM(5);
    if (IN(6)) { pg8::Gemm g{(const bf16*)(ws + WS_CAT), (const bf16*)(ws + WS_WO), M, D, D / 2, D, D / 256}; pg8::StaticOrder S; S.init(M, 2 * D, G, bid);
        pg8::EpiBf16<0> E{(bf16*)(ws + WS_MB), D, D / 256, (WS_Z - WS_MB) / 2, 0, 0}; pg8::gemm_phase<pg8::EpiBf16<0>, pg8::StaticOrder, true, true>(lds, g, S, E); }
    SEAM(6);
    if (IN(7)) p7_rows(a, G, bid, wave, lane);
    SEAM(7);
    if (IN(8)) { pg8::Gemm g{(const bf16*)(ws + WS_H), (const bf16*)(ws + WS_W1), M, DFF, D, D, DFF / 256}; pg8::StaticOrder S; S.init(M, DFF, G, bid);
        pg8::EpiBf16<2> E{(bf16*)(ws + WS_F1), DFF, DFF / 256, 0, 0, 0}; pg8::gemm_phase<pg8::EpiBf16<2>, pg8::StaticOrder, true, true>(lds, g, S, E); }
    SEAM(8);
    if (IN(9)) { pg8::Gemm g{(const bf16*)(ws + WS_F1), (const bf16*)(ws + WS_W2), M, D, DFF / 4, DFF, D / 256}; pg8::StaticOrder S; S.init(M, 4 * D, G, bid);
        pg8::EpiBf16<0> E{(bf16*)(ws + WS_MB), D, D / 256, (size_t)0 - (WS_MB - WS_CAT) / 2, (size_t)0 - (WS_MB - WS_H) / 2, (WS_P3 - WS_MB) / 2}; pg8::gemm_phase<pg8::EpiBf16<0>, pg8::StaticOrder, true, true>(lds, g, S, E); }
    SEAM(9);
    if (IN(10)) p10_rows(a, G, bid, wave, lane);
#undef IN
#undef SEAM
}

extern "C" void kernel_launch(void* const* d_in, const int* in_sizes, int n_in, void* d_out, int out_size, void* d_ws, size_t ws_size, hipStream_t stream) {
    static int grid = 0;
    if (grid == 0) {
        if (n_in != 19 || ws_size < WS_END) { fprintf(stderr, "kernel_launch: unexpected n_in %d / ws_size %zu\n", n_in, ws_size); grid = -1; return; }
        int dev = 0, cus = 0, per_cu = 0;
        hipGetDevice(&dev); hipDeviceGetAttribute(&cus, hipDeviceAttributeMultiprocessorCount, dev);
        if (hipFuncSetAttribute((const void*)fwd_megakernel, hipFuncAttributeMaxDynamicSharedMemorySize, LDS_BYTES) != hipSuccess) { fprintf(stderr, "kernel_launch: hipFuncSetAttribute failed\n"); grid = -1; return; }
        if (hipOccupancyMaxActiveBlocksPerMultiprocessor(&per_cu, (const void*)fwd_megakernel, NTHREADS, LDS_BYTES) != hipSuccess || per_cu < 1) { fprintf(stderr, "kernel_launch: occupancy query says %d\n", per_cu); per_cu = 1; }
        (void)hipGetLastError();
        grid = cus;
        fprintf(stderr, "kernel_launch: cus %d per_cu %d grid %d\n", cus, per_cu, grid);
    }
    if (grid < 0) return;
    if (hipMemsetAsync((char*)d_ws + WS_CTL, 0, CTL_ZERO_BYTES, stream) != hipSuccess) { fprintf(stderr, "kernel_launch: memset failed\n"); return; }
    Args a{};
    for (int i = 0; i < 19; ++i) a.in[i] = (const float*)d_in[i];
    a.out = (float*)d_out; a.ws = (unsigned char*)d_ws;
#if MK_MULTI
    for (int p = 0; p < NPHASE; ++p) { a.ph_lo = p; a.ph_hi = p + 1; void* args[] = {&a};
        hipError_t e = hipLaunchCooperativeKernel((const void*)fwd_megakernel, dim3(grid), dim3(NTHREADS), args, LDS_BYTES, stream);
        if (e != hipSuccess) { fprintf(stderr, "launch %d failed: %s\n", p, hipGetErrorString(e)); break; } }
#else
    a.ph_lo = 0; a.ph_hi = NPHASE; void* args[] = {&a};
    hipError_t e = hipLaunchCooperativeKernel((const void*)fwd_megakernel, dim3(grid), dim3(NTHREADS), args, LDS_BYTES, stream);
    if (e != hipSuccess) fprintf(stderr, "cooperative launch failed: %s (grid %d)\n", hipGetErrorString(e), grid);
#endif
}
```
